# Optimizing an MI355X kernel written in HIP

```python
import jax, jax.numpy as jnp
from jax import lax
import numpy as np

D_MODEL = 1024
BATCH = 4
SEQ = 8192
DEPTH = 1

N_HEADS = 8
HEAD_DIM = 64
N_KV_HEADS = 2
GQA_GROUP = N_HEADS // N_KV_HEADS
ATTN_WIDTH = N_HEADS * HEAD_DIM
WINDOW = 128
BLOCK = 128
CONV_WIDTH = D_MODEL - ATTN_WIDTH
CONV_GROUPS = 8
CONV_K = 3
MIX_WIDTH = ATTN_WIDTH + CONV_WIDTH
KV_WIDTH = N_KV_HEADS * HEAD_DIM
IN_COLS = ATTN_WIDTH + 2 * KV_WIDTH + 3 * CONV_WIDTH
D_FF = 4 * D_MODEL
EPS = 1e-6
NEG_INF = -1e30

kernel_name = "hymba_swa_sink_shortconv_relu2"


def rms_norm(x, g):
    xf = x.astype(jnp.float32)
    y = xf * lax.rsqrt(jnp.mean(xf * xf, axis=-1, keepdims=True) + EPS)
    return (y * g.astype(jnp.float32)).astype(x.dtype)


def swa_sink_attention(q, k, v, sinks):
    b, s = q.shape[0], q.shape[1]
    nb = s // BLOCK
    qb = q.reshape(b, nb, BLOCK, N_KV_HEADS, GQA_GROUP, HEAD_DIM)
    pad = ((0, 0), (BLOCK, 0), (0, 0), (0, 0))
    kp = jnp.pad(k, pad).reshape(b, nb + 1, BLOCK, N_KV_HEADS, HEAD_DIM)
    vp = jnp.pad(v, pad).reshape(b, nb + 1, BLOCK, N_KV_HEADS, HEAD_DIM)
    kw = jnp.concatenate([kp[:, :-1], kp[:, 1:]], axis=2)
    vw = jnp.concatenate([vp[:, :-1], vp[:, 1:]], axis=2)
    scale = HEAD_DIM ** -0.5
    sc = jnp.einsum('bnqhgd,bnkhd->bnhgqk', qb, kw).astype(jnp.float32) * scale
    blk = jnp.arange(nb)[:, None] * BLOCK
    qpos = blk + jnp.arange(BLOCK)[None, :]
    kpos = blk - BLOCK + jnp.arange(2 * BLOCK)[None, :]
    delta = qpos[:, :, None] - kpos[:, None, :]
    mask = (delta >= 0) & (delta < WINDOW) & (kpos[:, None, :] >= 0)
    sc = jnp.where(mask[None, :, None, None], sc, NEG_INF)
    sink = jnp.broadcast_to(sinks.astype(jnp.float32).reshape(1, 1, N_KV_HEADS, GQA_GROUP, 1, 1),
                            sc.shape[:-1] + (1,))
    p = jax.nn.softmax(jnp.concatenate([sc, sink], axis=-1), axis=-1)[..., :-1]
    o = jnp.einsum('bnhgqk,bnkhd->bnqhgd', p.astype(v.dtype), vw)
    return o.reshape(b, s, ATTN_WIDTH)


def short_conv(u, w):
    s = u.shape[1]
    up = jnp.pad(u, ((0, 0), (CONV_K - 1, 0), (0, 0)))
    out = w[0] * up[:, 0:s]
    for i in range(1, CONV_K):
        out = out + w[i] * up[:, i:i + s]
    return out


def setup_inputs(seed: int = 0) -> dict:
    key = jax.random.key(seed)
    ks = jax.random.split(key, 14)
    f32 = jnp.float32
    def nrm(k, shape, scale):
        return jax.random.normal(k, shape, f32) * scale
    return {
        "x": nrm(ks[0], (BATCH, SEQ, D_MODEL), 1.0),
        "attn_norm_g": 1.0 + nrm(ks[1], (DEPTH, D_MODEL), 0.02),
        "w_in": nrm(ks[2], (DEPTH, D_MODEL, IN_COLS), D_MODEL ** -0.5),
        "q_norm_g": 1.0 + nrm(ks[3], (DEPTH, HEAD_DIM), 0.02),
        "k_norm_g": 1.0 + nrm(ks[4], (DEPTH, HEAD_DIM), 0.02),
        "sinks": nrm(ks[5], (DEPTH, N_HEADS), 0.5),
        "conv_w": nrm(ks[6], (DEPTH, CONV_K, CONV_WIDTH), CONV_K ** -0.5),
        "attn_out_g": 1.0 + nrm(ks[7], (DEPTH, ATTN_WIDTH), 0.02),
        "conv_out_g": 1.0 + nrm(ks[8], (DEPTH, CONV_WIDTH), 0.02),
        "w_out": nrm(ks[9], (DEPTH, MIX_WIDTH, D_MODEL), MIX_WIDTH ** -0.5),
        "mlp_norm_g": 1.0 + nrm(ks[10], (DEPTH, D_MODEL), 0.02),
        "w_up": nrm(ks[11], (DEPTH, D_MODEL, D_FF), D_MODEL ** -0.5),
        "w_down": nrm(ks[12], (DEPTH, D_FF, D_MODEL), D_FF ** -0.5),
    }


def reference(x, attn_norm_g, w_in, q_norm_g, k_norm_g, sinks, conv_w,
              attn_out_g, conv_out_g, w_out, mlp_norm_g, w_up, w_down):
    b, s, _ = x.shape
    for l in range(DEPTH):
        h = rms_norm(x, attn_norm_g[l])
        z = h @ w_in[l]
        o0 = ATTN_WIDTH
        o1 = o0 + KV_WIDTH
        o2 = o1 + KV_WIDTH
        o3 = o2 + CONV_WIDTH
        o4 = o3 + CONV_WIDTH
        q = z[..., :o0].reshape(b, s, N_HEADS, HEAD_DIM)
        k = z[..., o0:o1].reshape(b, s, N_KV_HEADS, HEAD_DIM)
        v = z[..., o1:o2].reshape(b, s, N_KV_HEADS, HEAD_DIM)
        gate_b = z[..., o2:o3]
        gate_c = z[..., o3:o4]
        xc = z[..., o4:]
        q = rms_norm(q, q_norm_g[l])
        k = rms_norm(k, k_norm_g[l])
        y_attn = swa_sink_attention(q, k, v, sinks[l])
        y_conv = gate_b * short_conv(gate_c * xc, conv_w[l])
        y = jnp.concatenate([rms_norm(y_attn, attn_out_g[l]),
                             rms_norm(y_conv, conv_out_g[l])], axis=-1)
        x = x + y @ w_out[l]
        hm = rms_norm(x, mlp_norm_g[l])
        x = x + jnp.square(jax.nn.relu(hm @ w_up[l])) @ w_down[l]
    return x
```

```cpp
#include <hip/hip_runtime.h>
#include <hip/hip_cooperative_groups.h>
#include <cstdio>
#include <cstdint>
namespace cg = cooperative_groups;
namespace pg8 {
#define PG8_LAS __attribute__((address_space(3)))
typedef unsigned short bf16_t;
typedef short bf16x8 __attribute__((ext_vector_type(8)));
typedef float f32x4 __attribute__((ext_vector_type(4)));
typedef unsigned u32x4 __attribute__((ext_vector_type(4)));
constexpr int BM = 256, BK = 64, HALF = 128, HTB = HALF * BK * 2  , STAGE_BYTES = 8 * HTB, NXCD = 8, WGM = 8;

__host__ __device__ __forceinline__ int lds_byte(int r, int c) { const int st = (r >> 4) * 2 + (c >> 5), rr = r & 15, cc = c & 31, ob = rr * 64 + cc * 2; return st * 1024 + (ob ^ (((ob >> 9) & 1) << 5)); }
__host__ __device__ __forceinline__ void stage_rc(int b, int& R, int& C) { const int st = b / 1024, sb = b % 1024, swz = sb ^ (((sb >> 9) & 1) << 5); R = (st >> 1) * 16 + swz / 64; C = (st & 1) * 32 + (swz % 64) / 2; }
__host__ __device__ __forceinline__ int perm32(int rho) { const int n = rho >> 4, i = rho & 15; return 8 * (i >> 2) + 4 * n + (i & 3); }

struct Unit { int pm, pn; };
struct Gemm { const bf16_t* A; const bf16_t* Bt; int M, N, K; };

struct StaticOrder {
    int nM, nN, nwg, G, c;
    __host__ __device__ void init(int M, int N, int G_, int c_) { nM = M / BM; nN = N / BM; nwg = nM * nN; G = G_; c = c_; }
    int sh = 0;
    __host__ __device__ bool next(int i_, Unit& u) const {
        int i = i_; if (sh) { const int nr = (nwg - c + G - 1) / G; if (i >= 2 * nr) return false; if (i >= nr) i -= nr; }
        const long L = (long)i * G + c; if (L >= nwg) return false;
        int wgid = (int)L; { const int q = nwg / NXCD, r = nwg % NXCD, xcd = wgid % NXCD, off = wgid / NXCD; wgid = (xcd < r ? xcd * (q + 1) : r * (q + 1) + (xcd - r) * q) + off; }
        const int nig = WGM * nN, gid = wgid / nig, fm = gid * WGM, gsz = (nM - fm) < WGM ? (nM - fm) : WGM;
        u.pm = fm + ((wgid % nig) % gsz); u.pn = (wgid % nig) / gsz; return true;
    }
    __device__ __forceinline__ void a_ready(const Unit&) const {}
    __device__ __forceinline__ void done(const Unit&) const {}
};

__device__ __forceinline__ unsigned cvt_pk_bf16(float lo, float hi) { unsigned r; asm volatile("v_cvt_pk_bf16_f32 %0, %1, %2" : "=v"(r) : "v"(lo), "v"(hi)); return r; }
typedef float f32x2 __attribute__((ext_vector_type(2)));

struct GroupOrder {
    int nN, pm0, k, gs, n;
    int rev = 0;
    __device__ __forceinline__ void init(int nN_, int pm0_, int np_, int G, int c) { nN = nN_; pm0 = pm0_; k = c >> 3; gs = (G - (c & 7) + 7) >> 3; n = np_ * nN_; }
    __device__ __forceinline__ bool next(int i, Unit& u) const {
        const int j = i * gs + k; if (j >= n) return false;
        const int per = 8 * nN, blk = j / per, r = j - blk * per, nb = n / per;
        u.pm = pm0 + (rev ? nb - 1 - blk : blk) * 8 + (r & 7); u.pn = r >> 3; return true;
    }
    __device__ __forceinline__ void a_ready(const Unit&) const {}
    __device__ __forceinline__ void done(const Unit&) const {}
};
__host__ __device__ __forceinline__ size_t blk_off(int row, int col, int K) { return ((size_t)(row >> 8) * (K >> 6) + (col >> 6)) * (256 * 64) + (size_t)(row & 255) * 64 + (col & 63); }
struct EpiStoreZ {
    static constexpr bool PERM = true, AFTER_DRAIN = false, MID = false;
    bf16_t* O; int ldc;
    __device__ __forceinline__ void mid(f32x4 (&)[2][2][4][2], const Unit&, int, int, int, int) const {}
    __device__ __forceinline__ void operator()(const f32x4 (&acc)[2][2][4][2], const Unit& u, int wr, int wc, int fr, int fq) const {
        const int row0 = u.pm * BM + wr * 64 + fr;
        if (u.pn < 5) {
            const int col0 = u.pn * BM + wc * 32 + 8 * fq;
#pragma unroll
            for (int ai = 0; ai < 2; ++ai)
#pragma unroll
                for (int m = 0; m < 4; ++m) { bf16_t* rowp = O + (size_t)(row0 + ai * HALF + m * 16) * ldc + col0;
#pragma unroll
                    for (int bj = 0; bj < 2; ++bj) { const f32x4 v0 = acc[ai][bj][m][0], v1 = acc[ai][bj][m][1];
                        u32x4 w; w.x = cvt_pk_bf16(v0[0], v0[1]); w.y = cvt_pk_bf16(v0[2], v0[3]); w.z = cvt_pk_bf16(v1[0], v1[1]); w.w = cvt_pk_bf16(v1[2], v1[3]);
                        *(u32x4*)(rowp + bj * HALF) = w; } }
        } else {
            const int col0 = 1280 + (u.pn - 5) * HALF + wc * 32 + 8 * fq;
#pragma unroll
            for (int ai = 0; ai < 2; ++ai)
#pragma unroll
                for (int m = 0; m < 4; ++m) { const f32x4 v0 = acc[ai][0][m][0] * acc[ai][1][m][0], v1 = acc[ai][0][m][1] * acc[ai][1][m][1];
                    u32x4 w; w.x = cvt_pk_bf16(v0[0], v0[1]); w.y = cvt_pk_bf16(v0[2], v0[3]); w.z = cvt_pk_bf16(v1[0], v1[1]); w.w = cvt_pk_bf16(v1[2], v1[3]);
                    *(u32x4*)(O + (size_t)(row0 + ai * HALF + m * 16) * ldc + col0) = w; }
        }
    }
};
struct EpiRelu2 {
    static constexpr bool PERM = true, AFTER_DRAIN = false, MID = false;
    bf16_t* O; int ldc; const float* part; float eps;
    __device__ __forceinline__ void mid(f32x4 (&)[2][2][4][2], const Unit&, int, int, int, int) const {}
    __device__ __forceinline__ void operator()(const f32x4 (&acc)[2][2][4][2], const Unit& u, int wr, int wc, int fr, int fq) const {
        const int row0 = u.pm * BM + wr * 64 + fr, col0 = u.pn * BM + wc * 32 + 8 * fq;
        f32x4 pv[2][4];
#pragma unroll
        for (int ai = 0; ai < 2; ++ai)
#pragma unroll
            for (int m = 0; m < 4; ++m) pv[ai][m] = __builtin_nontemporal_load((const f32x4*)(part + (size_t)(row0 + ai * HALF + m * 16) * 16 + 4 * fq));
        float r2[2][4];
#pragma unroll
        for (int ai = 0; ai < 2; ++ai)
#pragma unroll
            for (int m = 0; m < 4; ++m) { float s = (pv[ai][m][0] + pv[ai][m][1]) + (pv[ai][m][2] + pv[ai][m][3]); s += __shfl_xor(s, 16); s += __shfl_xor(s, 32); r2[ai][m] = 1.0f / (s * (1.0f / 1024.0f) + eps); }
#pragma unroll
        for (int ai = 0; ai < 2; ++ai)
#pragma unroll
            for (int m = 0; m < 4; ++m) { const int row = row0 + ai * HALF + m * 16; const float rr = r2[ai][m];
                bf16_t* rowp = O + ((size_t)u.pm * (ldc / 64) * 256 + (size_t)(row - u.pm * BM)) * 64 + (size_t)(col0 >> 6) * (256 * 64) + (col0 & 63);
#pragma unroll
                for (int bj = 0; bj < 2; ++bj) { f32x4 v0 = acc[ai][bj][m][0], v1 = acc[ai][bj][m][1];
#pragma unroll
                    for (int e = 0; e < 4; ++e) { const float a = fmaxf(v0[e], 0.f), b = fmaxf(v1[e], 0.f); v0[e] = a * a * rr; v1[e] = b * b * rr; }
                    u32x4 w; w.x = cvt_pk_bf16(v0[0], v0[1]); w.y = cvt_pk_bf16(v0[2], v0[3]); w.z = cvt_pk_bf16(v1[0], v1[1]); w.w = cvt_pk_bf16(v1[2], v1[3]);
                    *(u32x4*)(rowp + (size_t)bj * (2 * 256 * 64)) = w; } }
    }
};
struct EpiResid {
    static constexpr bool PERM = true, AFTER_DRAIN = false, MID = true;
    const bf16_t* xn; const float* rmsx; bf16_t* x1b; float* part; const float* ra;
    __device__ __forceinline__ void mid(f32x4 (&acc)[2][2][4][2], const Unit& u, int wr, int wc, int fr, int fq) const {
        const int row0 = u.pm * BM + wr * 64 + fr;
#pragma unroll
        for (int ai = 0; ai < 2; ++ai)
#pragma unroll
            for (int m = 0; m < 4; ++m) { const float r = ra[row0 + ai * HALF + m * 16];
#pragma unroll
                for (int bj = 0; bj < 2; ++bj)
#pragma unroll
                    for (int n = 0; n < 2; ++n) acc[ai][bj][m][n] = acc[ai][bj][m][n] * r; }
    }
    __device__ __forceinline__ void operator()(const f32x4 (&acc)[2][2][4][2], const Unit& u, int wr, int wc, int fr, int fq) const {
        const int row0 = u.pm * BM + wr * 64 + fr, col0 = u.pn * BM + wc * 32 + 8 * fq;
#pragma unroll
        for (int ai = 0; ai < 2; ++ai) {
            u32x4 xw[4][2]; float rq[4];
#pragma unroll
            for (int m = 0; m < 4; ++m) { const int row = row0 + ai * HALF + m * 16; rq[m] = rmsx[row];
#pragma unroll
                for (int bj = 0; bj < 2; ++bj) xw[m][bj] = __builtin_nontemporal_load((const u32x4*)(xn + (size_t)row * 1024 + col0 + bj * HALF)); }
            asm volatile("" ::: "memory");
#pragma unroll
            for (int m = 0; m < 4; ++m) { const int row = row0 + ai * HALF + m * 16; const size_t off = (size_t)row * 1024 + col0; float ss = 0.f; const float q = rq[m];
#pragma unroll
                for (int bj = 0; bj < 2; ++bj) { const u32x4 w = xw[m][bj];
                    const f32x4 x0 = (f32x4){__builtin_bit_cast(float, w.x << 16), __builtin_bit_cast(float, w.x & 0xffff0000u), __builtin_bit_cast(float, w.y << 16), __builtin_bit_cast(float, w.y & 0xffff0000u)};
                    const f32x4 x1 = (f32x4){__builtin_bit_cast(float, w.z << 16), __builtin_bit_cast(float, w.z & 0xffff0000u), __builtin_bit_cast(float, w.w << 16), __builtin_bit_cast(float, w.w & 0xffff0000u)};
                    const f32x4 v0 = x0 * q + acc[ai][bj][m][0], v1 = x1 * q + acc[ai][bj][m][1];
                    ss += (v0[0] * v0[0] + v0[1] * v0[1]) + (v0[2] * v0[2] + v0[3] * v0[3]) + (v1[0] * v1[0] + v1[1] * v1[1]) + (v1[2] * v1[2] + v1[3] * v1[3]);
                    u32x4 o; o.x = cvt_pk_bf16(v0[0], v0[1]); o.y = cvt_pk_bf16(v0[2], v0[3]); o.z = cvt_pk_bf16(v1[0], v1[1]); o.w = cvt_pk_bf16(v1[2], v1[3]);
                    *(u32x4*)(x1b + blk_off(row, col0 + bj * HALF, 1024)) = o; }
                ss += __shfl_xor(ss, 16); ss += __shfl_xor(ss, 32);
                if (fq == 0) part[(size_t)row * 16 + u.pn * 4 + wc] = ss; }
            asm volatile("" ::: "memory");
        }
    }
};
struct EpiFinal {
    static constexpr bool PERM = true, AFTER_DRAIN = false, MID = false;
    const bf16_t* x1b; float* out;
    __device__ __forceinline__ void mid(f32x4 (&)[2][2][4][2], const Unit&, int, int, int, int) const {}
    __device__ __forceinline__ void operator()(const f32x4 (&acc)[2][2][4][2], const Unit& u, int wr, int wc, int fr, int fq) const {
        const int row0 = u.pm * BM + wr * 64 + fr, col0 = u.pn * BM + wc * 32 + 8 * fq;
#pragma unroll
        for (int ai = 0; ai < 2; ++ai) {
            u32x4 xw[4][2];
#pragma unroll
            for (int m = 0; m < 4; ++m)
#pragma unroll
                for (int bj = 0; bj < 2; ++bj) xw[m][bj] = __builtin_nontemporal_load((const u32x4*)(x1b + blk_off(row0 + ai * HALF + m * 16, col0 + bj * HALF, 1024)));
            asm volatile("" ::: "memory");
#pragma unroll
            for (int m = 0; m < 4; ++m) { const size_t off = (size_t)(row0 + ai * HALF + m * 16) * 1024 + col0;
#pragma unroll
                for (int bj = 0; bj < 2; ++bj) {
                    const u32x4 w = xw[m][bj];
                    const f32x4 x0 = (f32x4){__builtin_bit_cast(float, w.x << 16), __builtin_bit_cast(float, w.x & 0xffff0000u), __builtin_bit_cast(float, w.y << 16), __builtin_bit_cast(float, w.y & 0xffff0000u)};
                    const f32x4 x1 = (f32x4){__builtin_bit_cast(float, w.z << 16), __builtin_bit_cast(float, w.z & 0xffff0000u), __builtin_bit_cast(float, w.w << 16), __builtin_bit_cast(float, w.w & 0xffff0000u)};
                    *(f32x4*)(out + off + bj * HALF) = x0 + acc[ai][bj][m][0]; *(f32x4*)(out + off + bj * HALF + 4) = x1 + acc[ai][bj][m][1]; } }
            asm volatile("" ::: "memory");
        }
    }
};
template <class Epi, class Sched, bool ALIGN_EPI = false, bool SP2 = false, bool ABLK = false>
__device__ __forceinline__ void gemm_phase(PG8_LAS unsigned char* lds, const Gemm g, const Sched& S, const Epi& E) {
    int tid_ = threadIdx.x; asm volatile("" : "+v"(tid_));
    const int tid = tid_, wid = __builtin_amdgcn_readfirstlane(tid >> 6), lane = tid & 63, wr = wid >> 2, wc = wid & 3, fr = lane & 15, fq = lane >> 4;
    const int K = g.K, nt = K / BK;
    unsigned voffA[2], voffB[2];
#pragma unroll
    for (int i = 0; i < 2; ++i) { int R, C; stage_rc(tid * 16 + i * 8192, R, C); const int Rb = Epi::PERM ? ((R & ~31) + perm32(R & 31)) : R;
        voffA[i] = (unsigned)(R * (ABLK ? BK : K) + C) * 2u; voffB[i] = (unsigned)(Rb * K + C) * 2u; }
    const size_t kstep = (size_t)(BK * 2);
    const size_t hstep = (size_t)HALF * K * 2;
    const size_t tstep = 2 * hstep;
    const size_t kstepA = ABLK ? (size_t)(BM * BK * 2) : kstep, hstepA = ABLK ? (size_t)(HALF * BK * 2) : hstep, tstepA = ABLK ? (size_t)nt * (BM * BK * 2) : tstep;
    const unsigned ldsw = (unsigned)wid * 1024u;
    const int aoff = lds_byte(wr * 64 + fr, fq * 8), boff = lds_byte(wc * 32 + fr, fq * 8);
#define PG8_SA(b, h) (((b) * 2 + (h)) * HTB)
#define PG8_SB(b, h) ((4 + (b) * 2 + (h)) * HTB)
#define PG8_STAGE(bufoff, gbase, voff) do { _Pragma("unroll") for (int _i = 0; _i < 2; ++_i) \
        __builtin_amdgcn_global_load_lds((const unsigned*)((const char*)(gbase) + (voff)[_i]), (PG8_LAS unsigned*)(lds + (bufoff) + ldsw + _i * 8192), 16, 0, 0); } while (0)
#define PG8_LDA(dst, b, h) do { _Pragma("unroll") for (int m = 0; m < 4; ++m) _Pragma("unroll") for (int k = 0; k < 2; ++k) dst[m][k] = *(const PG8_LAS bf16x8*)(lds + PG8_SA(b, h) + aoff + m * 2048 + k * 1024); } while (0)
#define PG8_LDB(dst, b, h) do { _Pragma("unroll") for (int n = 0; n < 2; ++n) _Pragma("unroll") for (int k = 0; k < 2; ++k) dst[n][k] = *(const PG8_LAS bf16x8*)(lds + PG8_SB(b, h) + boff + n * 2048 + k * 1024); } while (0)
#define PG8_MMA(ai, bj, At, Bt) do { __builtin_amdgcn_s_setprio(1); _Pragma("unroll") for (int m = 0; m < 4; ++m) _Pragma("unroll") for (int n = 0; n < 2; ++n) _Pragma("unroll") for (int k = 0; k < 2; ++k) \
        acc[ai][bj][m][n] = __builtin_amdgcn_mfma_f32_16x16x32_bf16(Bt[n][k], At[m][k], acc[ai][bj][m][n], 0, 0, 0); __builtin_amdgcn_s_setprio(0); } while (0)
#define PG8_WAIT_V(n) asm volatile("s_waitcnt vmcnt(" #n ")" ::: "memory")
#define PG8_WAIT_L(n) asm volatile("s_waitcnt lgkmcnt(" #n ")" ::: "memory")
#define PG8_BAR __builtin_amdgcn_s_barrier()
#define PG8_SCHED __builtin_amdgcn_sched_barrier(0)
    Unit cur, nxt; int ui = 0;
    if (!S.next(0, cur)) return;
    f32x4 acc[2][2][4][2];
#pragma unroll
    for (int a = 0; a < 2; ++a)
#pragma unroll
        for (int b = 0; b < 2; ++b)
#pragma unroll
            for (int m = 0; m < 4; ++m)
#pragma unroll
                for (int n = 0; n < 2; ++n) acc[a][b][m][n] = (f32x4){0.f, 0.f, 0.f, 0.f};
    bf16x8 At[4][2], B0[2][2], B1[2][2];
    const char* cA = (const char*)g.A + (size_t)cur.pm * tstepA; const char* cB = (const char*)g.Bt + (size_t)cur.pn * tstep;
    S.a_ready(cur);
    if constexpr (SP2) {
        PG8_STAGE(PG8_SB(0, 0), cB, voffB); PG8_STAGE(PG8_SB(0, 1), cB + hstep, voffB); PG8_STAGE(PG8_SA(0, 0), cA, voffA); PG8_STAGE(PG8_SA(0, 1), cA + hstepA, voffA);
        if (wr == 1) PG8_BAR;
        PG8_WAIT_V(2); PG8_BAR;
        PG8_STAGE(PG8_SB(1, 0), cB + kstep, voffB); PG8_STAGE(PG8_SA(1, 0), cA + kstepA, voffA); PG8_STAGE(PG8_SB(1, 1), cB + hstep + kstep, voffB);
        PG8_WAIT_V(6); PG8_BAR;
    } else {
        PG8_STAGE(PG8_SB(0, 0), cB, voffB); PG8_STAGE(PG8_SA(0, 0), cA, voffA); PG8_STAGE(PG8_SB(0, 1), cB + hstep, voffB); PG8_STAGE(PG8_SA(0, 1), cA + hstepA, voffA);
        if (wr == 1) PG8_BAR;
        PG8_WAIT_V(4); PG8_BAR;
        PG8_STAGE(PG8_SB(1, 0), cB + kstep, voffB); PG8_STAGE(PG8_SA(1, 0), cA + kstepA, voffA); PG8_STAGE(PG8_SB(1, 1), cB + hstep + kstep, voffB);
        PG8_WAIT_V(6); PG8_BAR;
    }
    for (;;) {
        const bool has_next = S.next(ui + 1, nxt);
        const char* nA = has_next ? (const char*)g.A + (size_t)nxt.pm * tstepA : cA; const char* nB = has_next ? (const char*)g.Bt + (size_t)nxt.pn * tstep : cB;
        for (int t = 0; t < nt; t += 2) {
            if constexpr (Epi::MID) { if (t == nt / 2) E.mid(acc, cur, wr, wc, fr, fq); }
            const bool last = (t == nt - 2);
            const char* a1 = cA + (size_t)(t + 1) * kstepA;
            const char* a2 = last ? nA : cA + (size_t)(t + 2) * kstepA; const char* b2 = last ? nB : cB + (size_t)(t + 2) * kstep;
            const char* a3 = a2 + kstepA; const char* b3 = b2 + kstep;
            if (last && has_next) S.a_ready(nxt);
            if constexpr (SP2) {
            PG8_LDB(B0, 0, 0); PG8_LDB(B1, 0, 1); PG8_SCHED; PG8_LDA(At, 0, 0); PG8_STAGE(PG8_SA(1, 1), a1 + hstepA, voffA);
            PG8_WAIT_V(8); PG8_WAIT_L(0); PG8_BAR; PG8_MMA(0, 0, At, B0); PG8_MMA(0, 1, At, B1); PG8_BAR; PG8_SCHED;
            PG8_LDA(At, 0, 1); PG8_STAGE(PG8_SB(0, 0), b2, voffB); PG8_STAGE(PG8_SB(0, 1), b2 + hstep, voffB); PG8_STAGE(PG8_SA(0, 0), a2, voffA);
            PG8_WAIT_V(8); PG8_WAIT_L(0); PG8_BAR; PG8_MMA(1, 0, At, B0); PG8_MMA(1, 1, At, B1); PG8_BAR; PG8_SCHED;
            PG8_LDB(B0, 1, 0); PG8_LDB(B1, 1, 1); PG8_SCHED; PG8_LDA(At, 1, 0); PG8_STAGE(PG8_SA(0, 1), a2 + hstepA, voffA);
            PG8_WAIT_V(8); PG8_WAIT_L(0); PG8_BAR; PG8_MMA(0, 0, At, B0); PG8_MMA(0, 1, At, B1); PG8_BAR; PG8_SCHED;
            PG8_LDA(At, 1, 1); PG8_STAGE(PG8_SB(1, 0), b3, voffB); PG8_STAGE(PG8_SB(1, 1), b3 + hstep, voffB); PG8_STAGE(PG8_SA(1, 0), a3, voffA);
            PG8_WAIT_V(8); PG8_WAIT_L(0); PG8_BAR; PG8_MMA(1, 0, At, B0); PG8_MMA(1, 1, At, B1); PG8_BAR; PG8_SCHED;
            } else {
            PG8_LDB(B0, 0, 0); PG8_SCHED; PG8_LDA(At, 0, 0); PG8_STAGE(PG8_SA(1, 1), a1 + hstepA, voffA);
            PG8_WAIT_L(8); PG8_BAR; PG8_WAIT_L(0); PG8_MMA(0, 0, At, B0); PG8_BAR; PG8_SCHED;
            PG8_LDB(B1, 0, 1); PG8_STAGE(PG8_SB(0, 0), b2, voffB);
            PG8_BAR; PG8_WAIT_L(0); PG8_MMA(0, 1, At, B1); PG8_BAR;
            PG8_LDA(At, 0, 1); PG8_STAGE(PG8_SA(0, 0), a2, voffA);
            PG8_BAR; PG8_WAIT_L(0); PG8_MMA(1, 0, At, B0); PG8_BAR; PG8_SCHED;
            PG8_STAGE(PG8_SB(0, 1), b2 + hstep, voffB);
            PG8_WAIT_V(6); PG8_BAR; PG8_MMA(1, 1, At, B1); PG8_BAR;
            PG8_LDB(B0, 1, 0); PG8_SCHED; PG8_LDA(At, 1, 0); PG8_STAGE(PG8_SA(0, 1), a2 + hstepA, voffA);
            PG8_WAIT_L(8); PG8_BAR; PG8_WAIT_L(0); PG8_MMA(0, 0, At, B0); PG8_BAR; PG8_SCHED;
            PG8_LDB(B1, 1, 1); PG8_STAGE(PG8_SB(1, 0), b3, voffB);
            PG8_BAR; PG8_WAIT_L(0); PG8_MMA(0, 1, At, B1); PG8_BAR;
            PG8_LDA(At, 1, 1); PG8_STAGE(PG8_SA(1, 0), a3, voffA);
            PG8_BAR; PG8_WAIT_L(0); PG8_MMA(1, 0, At, B0); PG8_BAR; PG8_SCHED;
            PG8_STAGE(PG8_SB(1, 1), b3 + hstep, voffB);
            PG8_WAIT_V(6); PG8_BAR; PG8_MMA(1, 1, At, B1); PG8_BAR;
            }
        }
        if constexpr (ALIGN_EPI) { if (wr == 0) PG8_BAR; }
        if constexpr (!Epi::AFTER_DRAIN) { E(acc, cur, wr, wc, fr, fq); S.done(cur); }
        if (!has_next) break;
#pragma unroll
        for (int a = 0; a < 2; ++a)
#pragma unroll
            for (int b = 0; b < 2; ++b)
#pragma unroll
                for (int m = 0; m < 4; ++m)
#pragma unroll
                    for (int n = 0; n < 2; ++n) acc[a][b][m][n] = (f32x4){0.f, 0.f, 0.f, 0.f};
        cur = nxt; cA = nA; cB = nB; ++ui;
        if constexpr (ALIGN_EPI) { if (wr == 1) PG8_BAR; }
    }
    PG8_WAIT_V(0);
    if constexpr (!ALIGN_EPI) { if (wr == 0) PG8_BAR; }
    PG8_BAR;
    if constexpr (Epi::AFTER_DRAIN) { E.fused(acc, cur, wr, wc, fr, fq, lds, wid, lane); S.done(cur); }
#undef PG8_SA
#undef PG8_SB
#undef PG8_STAGE
#undef PG8_LDA
#undef PG8_LDB
#undef PG8_MMA
#undef PG8_WAIT_V
#undef PG8_WAIT_L
#undef PG8_BAR
#undef PG8_SCHED
}
}


constexpr int NWAVES = 8;
constexpr int BATCH = 4, SEQ = 8192, D = 1024, M = BATCH * SEQ;
constexpr int NH = 8, HD = 64, NKV = 2, AW = 512, CW = 512, INC = 2304, FF = 4096;
constexpr int O_K = 512, O_V = 640, O_B = 768, O_U = 1280, ZLD = 1792;
constexpr float EPS = 1e-6f;
constexpr float LOG2E = 1.4426950408889634f;

constexpr size_t MiB = 1u << 20;
constexpr size_t WS_WIN = 2 * MiB, WS_WOUT = 8 * MiB, WS_WUP = 10 * MiB, WS_WDN = 18 * MiB;
constexpr size_t WS_PART = 26 * MiB;
constexpr size_t WS_RA = 28 * MiB;
constexpr size_t WS_RMSX = 29 * MiB;
constexpr size_t WS_X1B = 32 * MiB;
constexpr size_t WS_XN = 352 * MiB;
constexpr size_t WS_Z = 96 * MiB;
constexpr size_t WS_Y = 416 * MiB;
constexpr size_t WS_H = 96 * MiB;
constexpr size_t WS_END = 480 * MiB;

constexpr int LDS_BYTES = 147456;
constexpr int KS_STRIDE = 144, VT_STRIDE = 520;
constexpr int LDS_KS = 0, LDS_VT = 2 * 256 * KS_STRIDE, LDS_SS = LDS_VT + 2 * 64 * VT_STRIDE;
constexpr int LDS_MISC = LDS_BYTES - 64;
static_assert(LDS_SS + 128 * 8 * 4 <= LDS_MISC, "attention LDS map");

#define GAS __attribute__((address_space(1)))
#define LAS __attribute__((address_space(3)))
typedef unsigned short bf16;
typedef unsigned v4u __attribute__((ext_vector_type(4)));
typedef unsigned v2u __attribute__((ext_vector_type(2)));
typedef float f32x4 __attribute__((ext_vector_type(4)));
typedef float f32x16 __attribute__((ext_vector_type(16)));
typedef short bf16x8 __attribute__((ext_vector_type(8)));
#define LDS_WAIT() asm volatile("s_waitcnt lgkmcnt(0)" ::: "memory")
__device__ __forceinline__ unsigned f2bf(float f) { unsigned u = __builtin_bit_cast(unsigned, f); return (u + 0x7fffu + ((u >> 16) & 1u)) >> 16; }
__device__ __forceinline__ unsigned pk2(float lo, float hi) { return f2bf(lo) | (f2bf(hi) << 16); }
__device__ __forceinline__ float bflo(unsigned w) { return __builtin_bit_cast(float, w << 16); }
__device__ __forceinline__ float bfhi(unsigned w) { return __builtin_bit_cast(float, w & 0xffff0000u); }
__device__ __forceinline__ void unpack8(const v4u w, float (&f)[8]) { f[0] = bflo(w.x); f[1] = bfhi(w.x); f[2] = bflo(w.y); f[3] = bfhi(w.y); f[4] = bflo(w.z); f[5] = bfhi(w.z); f[6] = bflo(w.w); f[7] = bfhi(w.w); }
__device__ __forceinline__ float wave_sum(float v) {
#pragma unroll
    for (int o = 1; o < 64; o <<= 1) v += __shfl_xor(v, o);
    return v;
}

#define XB_TMO      128
#define XB_XCNT(j)  (256  + 64 * (j))
#define XB_XSUB(j)  (1280 + 64 * (j))
#define XB_XGEN(j)  (2304 + 64 * (j))
#define XB_TOP      3328
#define XB_TOPGEN   3392
#define XCD_BAR_WORDS 3456
#define XB_SPIN_CAP (1u << 18)

__device__ __forceinline__ unsigned xb_ld(unsigned* p)              { return __hip_atomic_load(p, __ATOMIC_RELAXED, __HIP_MEMORY_SCOPE_AGENT); }
__device__ __forceinline__ unsigned xb_add(unsigned* p, unsigned v) { return __hip_atomic_fetch_add(p, v, __ATOMIC_RELAXED, __HIP_MEMORY_SCOPE_AGENT); }
__device__ __forceinline__ unsigned xb_xcc_id() { return (unsigned)__builtin_amdgcn_s_getreg((3 << 11) | 20) & 0xFu; }
#define XB_SPIN(cond, bar) do { unsigned _sp = 0; while (cond) { __builtin_amdgcn_s_sleep(1); \
    if ((++_sp & 255u) == 0u) { if (xb_ld(&(bar)[XB_TMO])) break; if (_sp > XB_SPIN_CAP) { atomicAdd(&(bar)[XB_TMO], 1u); break; } } } } while (0)

struct XcdBarrier {
    unsigned* bar; unsigned x;
    volatile LAS unsigned* st;
};

__device__ __forceinline__ XcdBarrier xcd_barrier_post(unsigned* bar, volatile LAS unsigned* st) {
    XcdBarrier b; b.bar = bar; b.x = xb_xcc_id(); b.st = st;
    if (threadIdx.x == 0) (void)xb_add(&bar[XB_XCNT(b.x)], 1u);
    return b;
}
__device__ __forceinline__ void xcd_barrier_complete(unsigned* bar, unsigned x, unsigned& nloc, unsigned& nx) {
    const unsigned G = gridDim.x * gridDim.y * gridDim.z;
    unsigned sum, cnt, mine, sp = 0u;
    for (;;) {
        sum = 0u; cnt = 0u; mine = 0u;
#pragma unroll
        for (unsigned j = 0; j < 16; ++j) { const unsigned c = xb_ld(&bar[XB_XCNT(j)]); sum += c; cnt += (c > 0u) ? 1u : 0u; mine = (j == x) ? c : mine; }
        if (sum == G) break;
        __builtin_amdgcn_s_sleep(1);
        if ((++sp & 255u) == 0u) { if (xb_ld(&bar[XB_TMO])) break; if (sp > XB_SPIN_CAP) { atomicAdd(&bar[XB_TMO], 1u); break; } }
    }
    nloc = mine > 0u ? mine : 1u; nx = cnt > 0u ? cnt : 1u;
}

__device__ __forceinline__ void xcd_barrier(const XcdBarrier& b) {
    asm volatile("s_waitcnt vmcnt(0)" ::: "memory");
    __syncthreads();
    if (threadIdx.x == 0) {
        unsigned* bar = b.bar;
        __builtin_amdgcn_s_waitcnt(0);
        unsigned nloc = b.st[0], nx = b.st[1];
        if (nloc == 0u) { xcd_barrier_complete(bar, b.x, nloc, nx); b.st[0] = nloc; b.st[1] = nx; }
        const unsigned old = xb_add(&bar[XB_XSUB(b.x)], 1u);
        const unsigned gen = old / nloc;
        if (old + 1u == (gen + 1u) * nloc) {
            __builtin_amdgcn_fence(__ATOMIC_RELEASE, "agent");
            asm volatile("s_waitcnt vmcnt(0)" ::: "memory");
            const unsigned og = xb_add(&bar[XB_TOP], 1u);
            const unsigned tg = og / nx;
            if (og + 1u == (tg + 1u) * nx) xb_add(&bar[XB_TOPGEN], 1u);
            else XB_SPIN(xb_ld(&bar[XB_TOPGEN]) == tg, bar);
            __builtin_amdgcn_fence(__ATOMIC_ACQUIRE, "agent");
            xb_add(&bar[XB_XGEN(b.x)], 1u);
            asm volatile("s_waitcnt vmcnt(0)" ::: "memory");
        } else {
            XB_SPIN(xb_ld(&bar[XB_XGEN(b.x)]) == gen, bar);
            __builtin_amdgcn_fence(__ATOMIC_ACQUIRE, "agent");
            asm volatile("s_waitcnt vmcnt(0)" ::: "memory");
        }
    }
    __syncthreads();
}

__device__ __forceinline__ void group_barrier(unsigned* cnt, unsigned gs, bool light) {
    asm volatile("s_waitcnt vmcnt(0)" ::: "memory");
    __syncthreads();
    if (threadIdx.x == 0) {
        if (!light) { __builtin_amdgcn_fence(__ATOMIC_RELEASE, "agent"); asm volatile("s_waitcnt vmcnt(0)" ::: "memory"); }
        const unsigned old = xb_add(cnt, 1u);
        const unsigned target = (old / gs + 1u) * gs;
        unsigned sp = 0u;
        while (xb_ld(cnt) < target) { __builtin_amdgcn_s_sleep(1); if (++sp > (1u << 22)) break; }
        if (!light) { __builtin_amdgcn_fence(__ATOMIC_ACQUIRE, "agent"); asm volatile("s_waitcnt vmcnt(0)" ::: "memory"); }
    }
    __syncthreads();
}

struct Args { const float* in[13]; float* out; unsigned char* ws; int use_cg_sync; int pad; };

template <bool GATEPERM = false>
__device__ __forceinline__ void p0_transpose_item(const float* W, int K, int N, bf16* WT, const float* g0, const float* g1, int ksplit, LAS float* scr, int item, int lane) {
    const int nblk = N / 32, kb = item / nblk, nb = item % nblk, k0 = 64 * kb, n0 = 32 * nb;
    int sn0 = n0;
    if (GATEPERM && n0 >= 1280) { const int t = (n0 - 1280) >> 8, w = (n0 - 1280) & 255; sn0 = (w < 128) ? 1280 + 128 * t + w : 1792 + 128 * t + (w - 128); }
#pragma unroll 1
    for (int h = 0; h < 2; ++h) {
        float v[16];
        const float* Wp = W + (size_t)(k0 + 32 * h + (lane >> 5)) * N + sn0 + (lane & 31);
#pragma unroll
        for (int i = 0; i < 16; ++i) v[i] = __builtin_nontemporal_load(Wp + (size_t)(2 * i) * N);
#pragma unroll
        for (int i = 0; i < 16; ++i) { const int kk = 2 * (16 * h + i) + (lane >> 5); const int k = k0 + kk;
            const float g = g0 ? (k < ksplit ? g0[k] : g1[k - ksplit]) : 1.0f;
            scr[kk * 33 + (lane & 31)] = v[i] * g; }
    }
    LDS_WAIT(); asm volatile("" ::: "memory");
    const int c = lane & 7;
#pragma unroll
    for (int j = 0; j < 4; ++j) { const int n = (lane >> 3) + 8 * j; const LAS float* s = scr + (8 * c) * 33 + n;
        v4u o; o.x = pk2(s[0 * 33], s[1 * 33]); o.y = pk2(s[2 * 33], s[3 * 33]); o.z = pk2(s[4 * 33], s[5 * 33]); o.w = pk2(s[6 * 33], s[7 * 33]);
        *(GAS v4u*)(WT + (size_t)(n0 + n) * K + k0 + 8 * c) = o; }
    LDS_WAIT(); asm volatile("" ::: "memory");
}
template <int NR>
__device__ __forceinline__ void rms_rows_to_bf16(const float* x, bf16* xn, float* rmsx, const int (&rows)[NR], int lane) {
    f32x4 v[NR][4]; float q[NR];
#pragma unroll
    for (int r = 0; r < NR; ++r) { const GAS f32x4* xr = (const GAS f32x4*)(x + (size_t)rows[r] * D) + lane;
#pragma unroll
        for (int j = 0; j < 4; ++j) v[r][j] = __builtin_nontemporal_load(xr + 64 * j); }
#pragma unroll
    for (int r = 0; r < NR; ++r) { float s = 0.f;
#pragma unroll
        for (int j = 0; j < 4; ++j) s += (v[r][j].x * v[r][j].x + v[r][j].y * v[r][j].y) + (v[r][j].z * v[r][j].z + v[r][j].w * v[r][j].w);
        q[r] = sqrtf(wave_sum(s) * (1.f / D) + EPS); }
#pragma unroll
    for (int r = 0; r < NR; ++r) { const float rr = 1.0f / q[r]; if (lane == 0) rmsx[rows[r]] = q[r];
        GAS unsigned long long* o8 = (GAS unsigned long long*)(xn + (size_t)rows[r] * D) + lane;
#pragma unroll
        for (int j = 0; j < 4; ++j) o8[64 * j] = (unsigned long long)pk2(v[r][j].x * rr, v[r][j].y * rr) | ((unsigned long long)pk2(v[r][j].z * rr, v[r][j].w * rr) << 32); }
}

__device__ __forceinline__ void attn_conv_unit(LAS unsigned char* lds, int unit, const bf16* Z, bf16* Y, float* RA,
                                               const float* qg, const float* kg, const float* sinks, const float* convw) {
    const int tid = threadIdx.x, lane = tid & 63, wave = __builtin_amdgcn_readfirstlane(tid >> 6);
    const int b = unit >> 6, qb = unit & 63;
    const size_t tok0 = (size_t)b * SEQ + (size_t)qb * 128;
    {
        v4u kw[8], vw[8];
#pragma unroll
        for (int i = 0; i < 8; ++i) {
            const int c = tid + 512 * i, kvh = c >> 11, key = (c >> 3) & 255, part = c & 7;
            kw[i] = (v4u){0u, 0u, 0u, 0u};
            if ((qb > 0) || (key >= 128)) kw[i] = *(const GAS v4u*)(Z + (tok0 + key - 128) * ZLD + O_K + kvh * 64 + part * 8);
        }
#pragma unroll
        for (int i = 0; i < 8; ++i) {
            const int c = tid + 512 * i, kvh = c >> 11, key = (c >> 3) & 255, part = c & 7;
            float f[8]; unpack8(kw[i], f);
            float ss = 0.f;
#pragma unroll
            for (int e = 0; e < 8; ++e) ss += f[e] * f[e];
            ss += __shfl_xor(ss, 1); ss += __shfl_xor(ss, 2); ss += __shfl_xor(ss, 4);
            const float r = 1.0f / sqrtf(ss * (1.0f / 64.0f) + EPS);
            const f32x4 g0 = *(const f32x4*)(kg + part * 8), g1 = *(const f32x4*)(kg + part * 8 + 4);
            v4u o; o.x = pk2(f[0] * r * g0[0], f[1] * r * g0[1]); o.y = pk2(f[2] * r * g0[2], f[3] * r * g0[3]); o.z = pk2(f[4] * r * g1[0], f[5] * r * g1[1]); o.w = pk2(f[6] * r * g1[2], f[7] * r * g1[3]);
            *(LAS v4u*)(lds + LDS_KS + (kvh * 256 + key) * KS_STRIDE + part * 16) = o;
        }
#pragma unroll
        for (int i = 0; i < 8; ++i) {
            const int key = tid & 255, kp = (tid >> 8) + 2 * i, kvh = kp >> 3, part = kp & 7;
            vw[i] = (v4u){0u, 0u, 0u, 0u};
            if ((qb > 0) || (key >= 128)) vw[i] = *(const GAS v4u*)(Z + (tok0 + key - 128) * ZLD + O_V + kvh * 64 + part * 8);
        }
#pragma unroll
        for (int i = 0; i < 8; ++i) {
            const int key = tid & 255, kp = (tid >> 8) + 2 * i, kvh = kp >> 3, part = kp & 7;
            const v4u w = vw[i];
            LAS unsigned short* vt = (LAS unsigned short*)(lds + LDS_VT + (kvh * 64 + part * 8) * VT_STRIDE + key * 2);
            vt[0 * (VT_STRIDE / 2)] = (unsigned short)(w.x & 0xffffu); vt[1 * (VT_STRIDE / 2)] = (unsigned short)(w.x >> 16);
            vt[2 * (VT_STRIDE / 2)] = (unsigned short)(w.y & 0xffffu); vt[3 * (VT_STRIDE / 2)] = (unsigned short)(w.y >> 16);
            vt[4 * (VT_STRIDE / 2)] = (unsigned short)(w.z & 0xffffu); vt[5 * (VT_STRIDE / 2)] = (unsigned short)(w.z >> 16);
            vt[6 * (VT_STRIDE / 2)] = (unsigned short)(w.w & 0xffffu); vt[7 * (VT_STRIDE / 2)] = (unsigned short)(w.w >> 16);
        }
    }
    {
        const int c0 = 8 * lane;
        float w0[8], w1[8], w2[8];
        { const f32x4 a0 = *(const f32x4*)(convw + c0), a1 = *(const f32x4*)(convw + c0 + 4), b0 = *(const f32x4*)(convw + CW + c0), b1 = *(const f32x4*)(convw + CW + c0 + 4),
                      d0 = *(const f32x4*)(convw + 2 * CW + c0), d1 = *(const f32x4*)(convw + 2 * CW + c0 + 4);
#pragma unroll
          for (int e = 0; e < 4; ++e) { w0[e] = a0[e]; w0[4 + e] = a1[e]; w1[e] = b0[e]; w1[4 + e] = b1[e]; w2[e] = d0[e]; w2[4 + e] = d1[e]; } }
        const size_t tokw = tok0 + 16 * wave;
        float u1[8], u2[8];
#pragma unroll
        for (int e = 0; e < 8; ++e) { u1[e] = 0.f; u2[e] = 0.f; }
        if (qb > 0 || wave > 0) {
            unpack8(*(const GAS v4u*)(Z + (tokw - 1) * ZLD + O_U + c0), u1);
            unpack8(*(const GAS v4u*)(Z + (tokw - 2) * ZLD + O_U + c0), u2);
        }
#pragma unroll 4
        for (int i = 0; i < 16; ++i) {
            const size_t tok = tokw + i;
            float fb[8], fu[8];
            unpack8(__builtin_nontemporal_load((const GAS v4u*)(Z + tok * ZLD + O_B + c0)), fb); unpack8(__builtin_nontemporal_load((const GAS v4u*)(Z + tok * ZLD + O_U + c0)), fu);
            float ov[8]; float ss = 0.f;
#pragma unroll
            for (int e = 0; e < 8; ++e) { const float u0 = fu[e]; const float cv = w0[e] * u2[e] + w1[e] * u1[e] + w2[e] * u0; ov[e] = fb[e] * cv; ss += ov[e] * ov[e]; u2[e] = u1[e]; u1[e] = u0; }
            const float r = 1.0f / sqrtf(wave_sum(ss) * (1.0f / CW) + EPS);
            v4u o; o.x = pk2(ov[0] * r, ov[1] * r); o.y = pk2(ov[2] * r, ov[3] * r); o.z = pk2(ov[4] * r, ov[5] * r); o.w = pk2(ov[6] * r, ov[7] * r);
            *(GAS v4u*)(Y + tok * D + AW + c0) = o;
        }
    }
    __syncthreads();
    {
        const int h = wave, kvh = h >> 2, r32 = lane & 31, hi = lane >> 5;
        const float sink2 = sinks[h] * LOG2E;
        const LAS unsigned char* ksb = lds + LDS_KS + (kvh * 256 + r32) * KS_STRIDE + hi * 16;
        const LAS unsigned char* vtb = lds + LDS_VT + (kvh * 64 + r32) * VT_STRIDE + hi * 8;
        LAS float* SS = (LAS float*)(lds + LDS_SS);
#pragma unroll 1
        for (int j = 0; j < 4; ++j) {
            const size_t tokq = tok0 + 32 * j + r32;
            bf16x8 qf[4];
            {
                v4u qw[4]; float ss = 0.f;
#pragma unroll
                for (int ks = 0; ks < 4; ++ks) qw[ks] = __builtin_nontemporal_load((const GAS v4u*)(Z + tokq * ZLD + h * 64 + ks * 16 + hi * 8));
#pragma unroll
                for (int ks = 0; ks < 4; ++ks) { float f[8]; unpack8(qw[ks], f);
#pragma unroll
                    for (int e = 0; e < 8; ++e) ss += f[e] * f[e]; }
                ss += __shfl_xor(ss, 32);
                const float r = (1.0f / sqrtf(ss * (1.0f / 64.0f) + EPS)) * (0.125f * LOG2E);
#pragma unroll
                for (int ks = 0; ks < 4; ++ks) { float f[8]; unpack8(qw[ks], f);
                    const f32x4 g0 = *(const f32x4*)(qg + ks * 16 + hi * 8), g1 = *(const f32x4*)(qg + ks * 16 + hi * 8 + 4);
                    v4u o; o.x = pk2(f[0] * r * g0[0], f[1] * r * g0[1]); o.y = pk2(f[2] * r * g0[2], f[3] * r * g0[3]); o.z = pk2(f[4] * r * g1[0], f[5] * r * g1[1]); o.w = pk2(f[6] * r * g1[2], f[7] * r * g1[3]);
                    qf[ks] = __builtin_bit_cast(bf16x8, o); }
            }
            f32x16 s[5];
#pragma unroll
            for (int a = 0; a < 5; ++a) {
                f32x16 acc = {};
#pragma unroll
                for (int ks = 0; ks < 4; ++ks) {
                    const bf16x8 kf = *(const LAS bf16x8*)(ksb + (32 * (j + a)) * KS_STRIDE + ks * 32);
                    acc = __builtin_amdgcn_mfma_f32_32x32x16_bf16(kf, qf[ks], acc, 0, 0, 0);
                }
                s[a] = acc;
            }
            const float NEG = -1e30f;
#pragma unroll
            for (int r = 0; r < 16; ++r) { const int c = (r & 3) + 8 * (r >> 2) + 4 * hi;
                if (!(r32 < c)) s[0][r] = NEG;
                if (!(r32 >= c)) s[4][r] = NEG; }
            if (qb == 0) {
#pragma unroll
                for (int a = 0; a < 5; ++a) if (j + a < 4) {
#pragma unroll
                    for (int r = 0; r < 16; ++r) s[a][r] = NEG; }
            }
            float mx = sink2;
#pragma unroll
            for (int a = 0; a < 5; ++a)
#pragma unroll
                for (int r = 0; r < 16; ++r) mx = fmaxf(mx, s[a][r]);
            mx = fmaxf(mx, __shfl_xor(mx, 32));
            float l = 0.f;
#pragma unroll
            for (int a = 0; a < 5; ++a)
#pragma unroll
                for (int r = 0; r < 16; ++r) { const float p = __builtin_amdgcn_exp2f(s[a][r] - mx); s[a][r] = p; l += p; }
            l += __shfl_xor(l, 32);
            l += __builtin_amdgcn_exp2f(sink2 - mx);
            f32x16 o[2]; o[0] = (f32x16){}; o[1] = (f32x16){};
#pragma unroll
            for (int a = 0; a < 5; ++a)
#pragma unroll
                for (int h2 = 0; h2 < 2; ++h2) {
                    v4u pw; pw.x = pk2(s[a][8 * h2 + 0], s[a][8 * h2 + 1]); pw.y = pk2(s[a][8 * h2 + 2], s[a][8 * h2 + 3]); pw.z = pk2(s[a][8 * h2 + 4], s[a][8 * h2 + 5]); pw.w = pk2(s[a][8 * h2 + 6], s[a][8 * h2 + 7]);
                    const bf16x8 pf = __builtin_bit_cast(bf16x8, pw);
#pragma unroll
                    for (int dt = 0; dt < 2; ++dt) {
                        const LAS unsigned char* vp = vtb + dt * 32 * VT_STRIDE + (32 * (j + a) + 16 * h2) * 2;
                        const v2u lo = *(const LAS v2u*)(vp), hi2 = *(const LAS v2u*)(vp + 16);
                        const v4u vw = (v4u){lo.x, lo.y, hi2.x, hi2.y};
                        o[dt] = __builtin_amdgcn_mfma_f32_32x32x16_bf16(__builtin_bit_cast(bf16x8, vw), pf, o[dt], 0, 0, 0);
                    }
                }
            const float inv = 1.0f / l;
            float sq = 0.f;
#pragma unroll
            for (int dt = 0; dt < 2; ++dt)
#pragma unroll
                for (int r = 0; r < 16; ++r) { o[dt][r] *= inv; sq += o[dt][r] * o[dt][r]; }
            sq += __shfl_xor(sq, 32);
            if (hi == 0) SS[(32 * j + r32) * 8 + h] = sq;
            bf16* yrow = Y + tokq * D + h * 64 + 4 * hi;
#pragma unroll
            for (int dt = 0; dt < 2; ++dt)
#pragma unroll
                for (int g = 0; g < 4; ++g) { v2u w; w.x = pk2(o[dt][4 * g + 0], o[dt][4 * g + 1]); w.y = pk2(o[dt][4 * g + 2], o[dt][4 * g + 3]);
                    *(GAS v2u*)(yrow + 32 * dt + 8 * g) = w; }
        }
    }
    __syncthreads();
    if (tid < 128) { const LAS float* SS = (const LAS float*)(lds + LDS_SS) + tid * 8; float s = 0.f;
#pragma unroll
        for (int e = 0; e < 8; ++e) s += SS[e];
        RA[tok0 + tid] = 1.0f / sqrtf(s * (1.0f / AW) + EPS); }
    __syncthreads();
}

#ifndef REP_P0
#define REP_P0 1
#endif
#ifndef REP_P1
#define REP_P1 1
#endif
#ifndef REP_P2
#define REP_P2 1
#endif
#ifndef REP_P3
#define REP_P3 1
#endif
#ifndef REP_P4
#define REP_P4 1
#endif
#ifndef REP_P5
#define REP_P5 1
#endif
#ifndef MLP_SPLIT
#define MLP_SPLIT 2
#endif
#ifndef WS_TOP
#define WS_TOP 0
#endif
#ifndef LIGHT_SEAMS
#define LIGHT_SEAMS 1
#endif
#ifndef REP_SYNC
#define REP_SYNC 1
#endif
#define XSYNC() do { for (int _r = 0; _r < REP_SYNC; ++_r) { if (args.use_cg_sync) grid.sync(); else xcd_barrier(xbar); } } while (0)
__global__ void __launch_bounds__(NWAVES * 64, 2) hymba_fwd(Args args) {
    extern __shared__ __attribute__((aligned(16))) unsigned char lds_raw[];
    LAS unsigned char* lds = (LAS unsigned char*)lds_raw;
    cg::grid_group grid = cg::this_grid();
    const int tid = threadIdx.x, lane = tid & 63, wave = __builtin_amdgcn_readfirstlane(tid >> 6);
    const int G = gridDim.x, bx = blockIdx.x;
    unsigned char* ws = args.ws;
    const float* x = args.in[0]; const float* attn_norm_g = args.in[1]; const float* w_in = args.in[2]; const float* q_norm_g = args.in[3]; const float* k_norm_g = args.in[4];
    const float* sinks = args.in[5]; const float* conv_w = args.in[6]; const float* attn_out_g = args.in[7]; const float* conv_out_g = args.in[8]; const float* w_out = args.in[9];
    const float* mlp_norm_g = args.in[10]; const float* w_up = args.in[11]; const float* w_down = args.in[12];
    float* out = args.out;
    if (tid < 16) ((LAS unsigned*)(lds + LDS_MISC))[tid] = 0u;
    __syncthreads();
    const XcdBarrier xbar = xcd_barrier_post((unsigned*)ws, (volatile LAS unsigned*)(lds + LDS_MISC));
    if (tid == 0) __hip_atomic_fetch_or((unsigned*)ws + 4096 + 64 * (bx & 7) + 16, 1u << xbar.x, __ATOMIC_RELAXED, __HIP_MEMORY_SCOPE_AGENT);
    bf16* Win_t = (bf16*)(ws + WS_WIN); bf16* Wout_t = (bf16*)(ws + WS_WOUT); bf16* Wup_t = (bf16*)(ws + WS_WUP); bf16* Wdn_t = (bf16*)(ws + WS_WDN);
    float* PART = (float*)(ws + WS_PART); float* RA = (float*)(ws + WS_RA); float* RMSX = (float*)(ws + WS_RMSX);
    bf16* X1B = (bf16*)(ws + WS_X1B); bf16* XN = (bf16*)(ws + WS_XN); bf16* Z = (bf16*)out;     bf16* Y = (bf16*)(ws + WS_Y); bf16* H = (bf16*)(ws + WS_H);

    for (int rep = 0; rep < REP_P0; ++rep) {
        LAS float* scr = (LAS float*)(lds + wave * 16384);
        const int gw = bx * NWAVES + wave, NGW = G * NWAVES;
        constexpr int I_IN = (D / 64) * (INC / 32), I_OUT = (D / 64) * (D / 32);
        constexpr int NITEMS = I_IN + I_OUT;
        for (int it = gw; it < NITEMS; it += NGW) {
            int r = it;
            if (r < I_IN) { p0_transpose_item<true>(w_in, D, INC, Win_t, attn_norm_g, attn_norm_g, D, scr, r, lane); continue; } r -= I_IN;
            p0_transpose_item(w_out, D, D, Wout_t, attn_out_g, conv_out_g, AW, scr, r, lane);
        }
        for (int m = gw; m < M / 4; m += NGW) { const int rows[4] = {m, m + M / 4, m + M / 2, m + 3 * (M / 4)}; rms_rows_to_bf16<4>(x, XN, RMSX, rows, lane); }
    }
    XSYNC();
    {
        pg8::Gemm g{XN, Win_t, M, INC, D}; pg8::StaticOrder S; S.init(M, INC, G, bx); S.sh = REP_P1 - 1;
        pg8::EpiStoreZ E{Z, ZLD};
        pg8::gemm_phase<pg8::EpiStoreZ, pg8::StaticOrder, true, true>(lds, g, S, E);
        constexpr int NWG1 = (M / 256) * (INC / 256);
        const int nfull = NWG1 % G, nidle = G - nfull;
        if (bx >= nfull) {
            LAS float* scr = (LAS float*)(lds + wave * 16384);
            constexpr int I_UP = (D / 64) * (FF / 32), I_DN = (FF / 64) * (D / 32);
            for (int it = (bx - nfull) * NWAVES + wave; it < I_UP + I_DN; it += nidle * NWAVES) {
                if (it < I_UP) p0_transpose_item(w_up, D, FF, Wup_t, mlp_norm_g, mlp_norm_g, D, scr, it, lane);
                else p0_transpose_item(w_down, FF, D, Wdn_t, nullptr, nullptr, 0, scr, it - I_UP, lane);
            }
        }
    }
    XSYNC();
    const int gx = bx & 7; unsigned* gcnt = (unsigned*)ws + 4096 + 64 * gx; const unsigned gsz = (unsigned)((G - gx + 7) >> 3);
    const bool light = __builtin_amdgcn_readfirstlane((int)(__builtin_popcount(xb_ld(gcnt + 16)) == 1)) != 0 && LIGHT_SEAMS;
    unsigned* zdone = (unsigned*)ws + 5120;
    for (int j = bx >> 3; j < 32; j += (int)gsz) attn_conv_unit(lds, 32 * gx + j, Z, Y, RA, q_norm_g, k_norm_g, sinks, conv_w);
    group_barrier(gcnt, gsz, light);
    if (tid == 0) (void)xb_add(zdone, 1u);
    {
        pg8::Gemm g{Y, Wout_t, M, D, D}; pg8::GroupOrder S; S.init(D / 256, 16 * gx, 16, G, bx);
        pg8::EpiResid E{XN, RMSX, X1B, PART, RA};
        pg8::gemm_phase<pg8::EpiResid, pg8::GroupOrder, true, true>(lds, g, S, E);
    }
    group_barrier(gcnt, gsz, light);
    {
        pg8::Gemm g{X1B, Wup_t, M, FF, D}; pg8::GroupOrder S; S.init(FF / 256, 16 * gx, 16, G, bx);
        pg8::EpiRelu2 E{H, FF, PART, EPS};
        pg8::gemm_phase<pg8::EpiRelu2, pg8::GroupOrder, true, true, true>(lds, g, S, E);
    }
    group_barrier(gcnt, gsz, light);
    if (tid == 0) { unsigned sp = 0u; while (xb_ld(zdone) < (unsigned)G) { __builtin_amdgcn_s_sleep(1); if (++sp > (1u << 22)) break; } }
    __syncthreads();
    {
        pg8::Gemm g{H, Wdn_t, M, D, FF}; pg8::GroupOrder S; S.init(D / 256, 16 * gx, 16, G, bx); S.rev = 1;
        pg8::EpiFinal E{X1B, out};
        pg8::gemm_phase<pg8::EpiFinal, pg8::GroupOrder, true, true, true>(lds, g, S, E);
    }
}

extern "C" void kernel_launch(void* const* d_in, const int* in_sizes, int n_in, void* d_out, int out_size, void* d_ws, size_t ws_size, hipStream_t stream) {
    static int grid = 0;
    if (grid == 0) {
        if (n_in != 13 || in_sizes[0] != M * D || out_size != M * D || ws_size < WS_END || (M / 256) != 128) { fprintf(stderr, "kernel_launch: unexpected shapes (n_in %d, in0 %d, out %d, ws %zu); nothing launched\n", n_in, n_in > 0 ? in_sizes[0] : -1, out_size, ws_size); grid = -1; return; }
        int dev = 0, cus = 0, per_cu = 0;
        if (hipGetDevice(&dev) != hipSuccess || hipDeviceGetAttribute(&cus, hipDeviceAttributeMultiprocessorCount, dev) != hipSuccess) { grid = -1; return; }
        if (hipFuncSetAttribute((const void*)hymba_fwd, hipFuncAttributeMaxDynamicSharedMemorySize, LDS_BYTES) != hipSuccess) { fprintf(stderr, "kernel_launch: hipFuncSetAttribute failed\n"); grid = -1; return; }
        if (hipOccupancyMaxActiveBlocksPerMultiprocessor(&per_cu, (const void*)hymba_fwd, NWAVES * 64, LDS_BYTES) != hipSuccess || per_cu < 1) { fprintf(stderr, "kernel_launch: occupancy query gave %d\n", per_cu); per_cu = 1; }
        (void)hipGetLastError();
        grid = cus * 1;
        (void)per_cu;
    }
    if (grid < 0) return;
    unsigned char* wsb = (unsigned char*)d_ws + (WS_TOP ? ((ws_size - WS_END) & ~(size_t)(2 * MiB - 1)) : 0);
    if (hipMemsetAsync(wsb, 0, 32768, stream) != hipSuccess) { fprintf(stderr, "kernel_launch: memset failed\n"); return; }
    Args a{};
    for (int i = 0; i < 13; ++i) a.in[i] = (const float*)d_in[i];
    a.out = (float*)d_out; a.ws = wsb; a.use_cg_sync = 0; a.pad = 0;
    void* kargs[] = {&a};
    const hipError_t e = hipLaunchCooperativeKernel((const void*)hymba_fwd, dim3(grid), dim3(NWAVES * 64), kargs, LDS_BYTES, stream);
    if (e != hipSuccess) fprintf(stderr, "kernel_launch: cooperative launch failed: %s (grid %d)\n", hipGetErrorString(e), grid);
}
```

```cpp
#include <hip/hip_runtime.h>
#include <hip/hip_cooperative_groups.h>
#include <cstdio>
#include <cstdint>
namespace cg = cooperative_groups;
namespace pg8 {
#define PG8_LAS __attribute__((address_space(3)))
typedef unsigned short bf16_t;
typedef short bf16x8 __attribute__((ext_vector_type(8)));
typedef float f32x4 __attribute__((ext_vector_type(4)));
typedef unsigned u32x4 __attribute__((ext_vector_type(4)));
constexpr int BM = 256, BK = 64, HALF = 128, HTB = HALF * BK * 2  , STAGE_BYTES = 8 * HTB, NXCD = 8, WGM = 8;

__host__ __device__ __forceinline__ int lds_byte(int r, int c) { const int st = (r >> 4) * 2 + (c >> 5), rr = r & 15, cc = c & 31, ob = rr * 64 + cc * 2; return st * 1024 + (ob ^ (((ob >> 9) & 1) << 5)); }
__host__ __device__ __forceinline__ void stage_rc(int b, int& R, int& C) { const int st = b / 1024, sb = b % 1024, swz = sb ^ (((sb >> 9) & 1) << 5); R = (st >> 1) * 16 + swz / 64; C = (st & 1) * 32 + (swz % 64) / 2; }
__host__ __device__ __forceinline__ int perm32(int rho) { const int n = rho >> 4, i = rho & 15; return 8 * (i >> 2) + 4 * n + (i & 3); }

struct Unit { int pm, pn; };
struct Gemm { const bf16_t* A; const bf16_t* Bt; int M, N, K; };

struct StaticOrder {
    int nM, nN, nwg, G, c;
    __host__ __device__ void init(int M, int N, int G_, int c_) { nM = M / BM; nN = N / BM; nwg = nM * nN; G = G_; c = c_; }
    int sh = 0;
    __host__ __device__ bool next(int i_, Unit& u) const {
        int i = i_; if (sh) { const int nr = (nwg - c + G - 1) / G; if (i >= 2 * nr) return false; if (i >= nr) i -= nr; }
        const long L = (long)i * G + c; if (L >= nwg) return false;
        int wgid = (int)L; { const int q = nwg / NXCD, r = nwg % NXCD, xcd = wgid % NXCD, off = wgid / NXCD; wgid = (xcd < r ? xcd * (q + 1) : r * (q + 1) + (xcd - r) * q) + off; }
        const int nig = WGM * nN, gid = wgid / nig, fm = gid * WGM, gsz = (nM - fm) < WGM ? (nM - fm) : WGM;
        u.pm = fm + ((wgid % nig) % gsz); u.pn = (wgid % nig) / gsz; return true;
    }
    __device__ __forceinline__ void a_ready(const Unit&) const {}
    __device__ __forceinline__ void done(const Unit&) const {}
};

__device__ __forceinline__ unsigned cvt_pk_bf16(float lo, float hi) { unsigned r; asm volatile("v_cvt_pk_bf16_f32 %0, %1, %2" : "=v"(r) : "v"(lo), "v"(hi)); return r; }
typedef float f32x2 __attribute__((ext_vector_type(2)));

struct GroupOrder {
    int nN, pm0, k, gs, n;
    int rev = 0;
    __device__ __forceinline__ void init(int nN_, int pm0_, int np_, int G, int c) { nN = nN_; pm0 = pm0_; k = c >> 3; gs = (G - (c & 7) + 7) >> 3; n = np_ * nN_; }
    __device__ __forceinline__ bool next(int i, Unit& u) const {
        const int j = i * gs + k; if (j >= n) return false;
        const int per = 8 * nN, blk = j / per, r = j - blk * per, nb = n / per;
        u.pm = pm0 + (rev ? nb - 1 - blk : blk) * 8 + (r & 7); u.pn = r >> 3; return true;
    }
    __device__ __forceinline__ void a_ready(const Unit&) const {}
    __device__ __forceinline__ void done(const Unit&) const {}
};
__host__ __device__ __forceinline__ size_t blk_off(int row, int col, int K) { return ((size_t)(row >> 8) * (K >> 6) + (col >> 6)) * (256 * 64) + (size_t)(row & 255) * 64 + (col & 63); }
struct EpiStoreZ {
    static constexpr bool PERM = true, AFTER_DRAIN = false, MID = false;
    bf16_t* O; int ldc;
    __device__ __forceinline__ void mid(f32x4 (&)[2][2][4][2], const Unit&, int, int, int, int) const {}
    __device__ __forceinline__ void operator()(const f32x4 (&acc)[2][2][4][2], const Unit& u, int wr, int wc, int fr, int fq) const {
        const int row0 = u.pm * BM + wr * 64 + fr;
        if (u.pn < 5) {
            const int col0 = u.pn * BM + wc * 32 + 8 * fq;
#pragma unroll
            for (int ai = 0; ai < 2; ++ai)
#pragma unroll
                for (int m = 0; m < 4; ++m) { bf16_t* rowp = O + (size_t)(row0 + ai * HALF + m * 16) * ldc + col0;
#pragma unroll
                    for (int bj = 0; bj < 2; ++bj) { const f32x4 v0 = acc[ai][bj][m][0], v1 = acc[ai][bj][m][1];
                        u32x4 w; w.x = cvt_pk_bf16(v0[0], v0[1]); w.y = cvt_pk_bf16(v0[2], v0[3]); w.z = cvt_pk_bf16(v1[0], v1[1]); w.w = cvt_pk_bf16(v1[2], v1[3]);
                        *(u32x4*)(rowp + bj * HALF) = w; } }
        } else {
            const int col0 = 1280 + (u.pn - 5) * HALF + wc * 32 + 8 * fq;
#pragma unroll
            for (int ai = 0; ai < 2; ++ai)
#pragma unroll
                for (int m = 0; m < 4; ++m) { const f32x4 v0 = acc[ai][0][m][0] * acc[ai][1][m][0], v1 = acc[ai][0][m][1] * acc[ai][1][m][1];
                    u32x4 w; w.x = cvt_pk_bf16(v0[0], v0[1]); w.y = cvt_pk_bf16(v0[2], v0[3]); w.z = cvt_pk_bf16(v1[0], v1[1]); w.w = cvt_pk_bf16(v1[2], v1[3]);
                    *(u32x4*)(O + (size_t)(row0 + ai * HALF + m * 16) * ldc + col0) = w; }
        }
    }
};
struct EpiRelu2 {
    static constexpr bool PERM = true, AFTER_DRAIN = false, MID = false;
    bf16_t* O; int ldc; const float* part; float eps;
    __device__ __forceinline__ void mid(f32x4 (&)[2][2][4][2], const Unit&, int, int, int, int) const {}
    __device__ __forceinline__ void operator()(const f32x4 (&acc)[2][2][4][2], const Unit& u, int wr, int wc, int fr, int fq) const {
        const int row0 = u.pm * BM + wr * 64 + fr, col0 = u.pn * BM + wc * 32 + 8 * fq;
        f32x4 pv[2][4];
#pragma unroll
        for (int ai = 0; ai < 2; ++ai)
#pragma unroll
            for (int m = 0; m < 4; ++m) pv[ai][m] = __builtin_nontemporal_load((const f32x4*)(part + (size_t)(row0 + ai * HALF + m * 16) * 16 + 4 * fq));
        float r2[2][4];
#pragma unroll
        for (int ai = 0; ai < 2; ++ai)
#pragma unroll
            for (int m = 0; m < 4; ++m) { float s = (pv[ai][m][0] + pv[ai][m][1]) + (pv[ai][m][2] + pv[ai][m][3]); s += __shfl_xor(s, 16); s += __shfl_xor(s, 32); r2[ai][m] = 1.0f / (s * (1.0f / 1024.0f) + eps); }
#pragma unroll
        for (int ai = 0; ai < 2; ++ai)
#pragma unroll
            for (int m = 0; m < 4; ++m) { const int row = row0 + ai * HALF + m * 16; const float rr = r2[ai][m];
                bf16_t* rowp = O + ((size_t)u.pm * (ldc / 64) * 256 + (size_t)(row - u.pm * BM)) * 64 + (size_t)(col0 >> 6) * (256 * 64) + (col0 & 63);
#pragma unroll
                for (int bj = 0; bj < 2; ++bj) { f32x4 v0 = acc[ai][bj][m][0], v1 = acc[ai][bj][m][1];
#pragma unroll
                    for (int e = 0; e < 4; ++e) { const float a = fmaxf(v0[e], 0.f), b = fmaxf(v1[e], 0.f); v0[e] = a * a * rr; v1[e] = b * b * rr; }
                    u32x4 w; w.x = cvt_pk_bf16(v0[0], v0[1]); w.y = cvt_pk_bf16(v0[2], v0[3]); w.z = cvt_pk_bf16(v1[0], v1[1]); w.w = cvt_pk_bf16(v1[2], v1[3]);
                    *(u32x4*)(rowp + (size_t)bj * (2 * 256 * 64)) = w; } }
    }
};
struct EpiResid {
    static constexpr bool PERM = true, AFTER_DRAIN = false, MID = true;
    const bf16_t* xn; const float* rmsx; bf16_t* x1b; float* part; const float* ra;
    __device__ __forceinline__ void mid(f32x4 (&acc)[2][2][4][2], const Unit& u, int wr, int wc, int fr, int fq) const {
        const int row0 = u.pm * BM + wr * 64 + fr;
#pragma unroll
        for (int ai = 0; ai < 2; ++ai)
#pragma unroll
            for (int m = 0; m < 4; ++m) { const float r = ra[row0 + ai * HALF + m * 16];
#pragma unroll
                for (int bj = 0; bj < 2; ++bj)
#pragma unroll
                    for (int n = 0; n < 2; ++n) acc[ai][bj][m][n] = acc[ai][bj][m][n] * r; }
    }
    __device__ __forceinline__ void operator()(const f32x4 (&acc)[2][2][4][2], const Unit& u, int wr, int wc, int fr, int fq) const {
        const int row0 = u.pm * BM + wr * 64 + fr, col0 = u.pn * BM + wc * 32 + 8 * fq;
#pragma unroll
        for (int ai = 0; ai < 2; ++ai) {
            u32x4 xw[4][2]; float rq[4];
#pragma unroll
            for (int m = 0; m < 4; ++m) { const int row = row0 + ai * HALF + m * 16; rq[m] = rmsx[row];
#pragma unroll
                for (int bj = 0; bj < 2; ++bj) xw[m][bj] = __builtin_nontemporal_load((const u32x4*)(xn + (size_t)row * 1024 + col0 + bj * HALF)); }
            asm volatile("" ::: "memory");
#pragma unroll
            for (int m = 0; m < 4; ++m) { const int row = row0 + ai * HALF + m * 16; const size_t off = (size_t)row * 1024 + col0; float ss = 0.f; const float q = rq[m];
#pragma unroll
                for (int bj = 0; bj < 2; ++bj) { const u32x4 w = xw[m][bj];
                    const f32x4 x0 = (f32x4){__builtin_bit_cast(float, w.x << 16), __builtin_bit_cast(float, w.x & 0xffff0000u), __builtin_bit_cast(float, w.y << 16), __builtin_bit_cast(float, w.y & 0xffff0000u)};
                    const f32x4 x1 = (f32x4){__builtin_bit_cast(float, w.z << 16), __builtin_bit_cast(float, w.z & 0xffff0000u), __builtin_bit_cast(float, w.w << 16), __builtin_bit_cast(float, w.w & 0xffff0000u)};
                    const f32x4 v0 = x0 * q + acc[ai][bj][m][0], v1 = x1 * q + acc[ai][bj][m][1];
                    ss += (v0[0] * v0[0] + v0[1] * v0[1]) + (v0[2] * v0[2] + v0[3] * v0[3]) + (v1[0] * v1[0] + v1[1] * v1[1]) + (v1[2] * v1[2] + v1[3] * v1[3]);
                    u32x4 o; o.x = cvt_pk_bf16(v0[0], v0[1]); o.y = cvt_pk_bf16(v0[2], v0[3]); o.z = cvt_pk_bf16(v1[0], v1[1]); o.w = cvt_pk_bf16(v1[2], v1[3]);
                    *(u32x4*)(x1b + blk_off(row, col0 + bj * HALF, 1024)) = o; }
                ss += __shfl_xor(ss, 16); ss += __shfl_xor(ss, 32);
                if (fq == 0) part[(size_t)row * 16 + u.pn * 4 + wc] = ss; }
            asm volatile("" ::: "memory");
        }
    }
};
struct EpiFinal {
    static constexpr bool PERM = true, AFTER_DRAIN = false, MID = false;
    const bf16_t* x1b; float* out;
    __device__ __forceinline__ void mid(f32x4 (&)[2][2][4][2], const Unit&, int, int, int, int) const {}
    __device__ __forceinline__ void operator()(const f32x4 (&acc)[2][2][4][2], const Unit& u, int wr, int wc, int fr, int fq) const {
        const int row0 = u.pm * BM + wr * 64 + fr, col0 = u.pn * BM + wc * 32 + 8 * fq;
#pragma unroll
        for (int ai = 0; ai < 2; ++ai) {
            u32x4 xw[4][2];
#pragma unroll
            for (int m = 0; m < 4; ++m)
#pragma unroll
                for (int bj = 0; bj < 2; ++bj) xw[m][bj] = __builtin_nontemporal_load((const u32x4*)(x1b + blk_off(row0 + ai * HALF + m * 16, col0 + bj * HALF, 1024)));
            asm volatile("" ::: "memory");
#pragma unroll
            for (int m = 0; m < 4; ++m) { const size_t off = (size_t)(row0 + ai * HALF + m * 16) * 1024 + col0;
#pragma unroll
                for (int bj = 0; bj < 2; ++bj) {
                    const u32x4 w = xw[m][bj];
                    const f32x4 x0 = (f32x4){__builtin_bit_cast(float, w.x << 16), __builtin_bit_cast(float, w.x & 0xffff0000u), __builtin_bit_cast(float, w.y << 16), __builtin_bit_cast(float, w.y & 0xffff0000u)};
                    const f32x4 x1 = (f32x4){__builtin_bit_cast(float, w.z << 16), __builtin_bit_cast(float, w.z & 0xffff0000u), __builtin_bit_cast(float, w.w << 16), __builtin_bit_cast(float, w.w & 0xffff0000u)};
                    *(f32x4*)(out + off + bj * HALF) = x0 + acc[ai][bj][m][0]; *(f32x4*)(out + off + bj * HALF + 4) = x1 + acc[ai][bj][m][1]; } }
            asm volatile("" ::: "memory");
        }
    }
};
template <class Epi, class Sched, bool ALIGN_EPI = false, bool SP2 = false, bool ABLK = false>
__device__ __forceinline__ void gemm_phase(PG8_LAS unsigned char* lds, const Gemm g, const Sched& S, const Epi& E) {
    int tid_ = threadIdx.x; asm volatile("" : "+v"(tid_));
    const int tid = tid_, wid = __builtin_amdgcn_readfirstlane(tid >> 6), lane = tid & 63, wr = wid >> 2, wc = wid & 3, fr = lane & 15, fq = lane >> 4;
    const int K = g.K, nt = K / BK;
    unsigned voffA[2], voffB[2];
#pragma unroll
    for (int i = 0; i < 2; ++i) { int R, C; stage_rc(tid * 16 + i * 8192, R, C); const int Rb = Epi::PERM ? ((R & ~31) + perm32(R & 31)) : R;
        voffA[i] = (unsigned)(R * (ABLK ? BK : K) + C) * 2u; voffB[i] = (unsigned)(Rb * K + C) * 2u; }
    const size_t kstep = (size_t)(BK * 2);
    const size_t hstep = (size_t)HALF * K * 2;
    const size_t tstep = 2 * hstep;
    const size_t kstepA = ABLK ? (size_t)(BM * BK * 2) : kstep, hstepA = ABLK ? (size_t)(HALF * BK * 2) : hstep, tstepA = ABLK ? (size_t)nt * (BM * BK * 2) : tstep;
    const unsigned ldsw = (unsigned)wid * 1024u;
    const int aoff = lds_byte(wr * 64 + fr, fq * 8), boff = lds_byte(wc * 32 + fr, fq * 8);
#define PG8_SA(b, h) (((b) * 2 + (h)) * HTB)
#define PG8_SB(b, h) ((4 + (b) * 2 + (h)) * HTB)
#define PG8_STAGE(bufoff, gbase, voff) do { _Pragma("unroll") for (int _i = 0; _i < 2; ++_i) \
        __builtin_amdgcn_global_load_lds((const unsigned*)((const char*)(gbase) + (voff)[_i]), (PG8_LAS unsigned*)(lds + (bufoff) + ldsw + _i * 8192), 16, 0, 0); } while (0)
#define PG8_LDA(dst, b, h) do { _Pragma("unroll") for (int m = 0; m < 4; ++m) _Pragma("unroll") for (int k = 0; k < 2; ++k) dst[m][k] = *(const PG8_LAS bf16x8*)(lds + PG8_SA(b, h) + aoff + m * 2048 + k * 1024); } while (0)
#define PG8_LDB(dst, b, h) do { _Pragma("unroll") for (int n = 0; n < 2; ++n) _Pragma("unroll") for (int k = 0; k < 2; ++k) dst[n][k] = *(const PG8_LAS bf16x8*)(lds + PG8_SB(b, h) + boff + n * 2048 + k * 1024); } while (0)
#define PG8_MMA(ai, bj, At, Bt) do { __builtin_amdgcn_s_setprio(1); _Pragma("unroll") for (int m = 0; m < 4; ++m) _Pragma("unroll") for (int n = 0; n < 2; ++n) _Pragma("unroll") for (int k = 0; k < 2; ++k) \
        acc[ai][bj][m][n] = __builtin_amdgcn_mfma_f32_16x16x32_bf16(Bt[n][k], At[m][k], acc[ai][bj][m][n], 0, 0, 0); __builtin_amdgcn_s_setprio(0); } while (0)
#define PG8_WAIT_V(n) asm volatile("s_waitcnt vmcnt(" #n ")" ::: "memory")
#define PG8_WAIT_L(n) asm volatile("s_waitcnt lgkmcnt(" #n ")" ::: "memory")
#define PG8_BAR __builtin_amdgcn_s_barrier()
#define PG8_SCHED __builtin_amdgcn_sched_barrier(0)
    Unit cur, nxt; int ui = 0;
    if (!S.next(0, cur)) return;
    f32x4 acc[2][2][4][2];
#pragma unroll
    for (int a = 0; a < 2; ++a)
#pragma unroll
        for (int b = 0; b < 2; ++b)
#pragma unroll
            for (int m = 0; m < 4; ++m)
#pragma unroll
                for (int n = 0; n < 2; ++n) acc[a][b][m][n] = (f32x4){0.f, 0.f, 0.f, 0.f};
    bf16x8 At[4][2], B0[2][2], B1[2][2];
    const char* cA = (const char*)g.A + (size_t)cur.pm * tstepA; const char* cB = (const char*)g.Bt + (size_t)cur.pn * tstep;
    S.a_ready(cur);
    if constexpr (SP2) {
        PG8_STAGE(PG8_SB(0, 0), cB, voffB); PG8_STAGE(PG8_SB(0, 1), cB + hstep, voffB); PG8_STAGE(PG8_SA(0, 0), cA, voffA); PG8_STAGE(PG8_SA(0, 1), cA + hstepA, voffA);
        if (wr == 1) PG8_BAR;
        PG8_WAIT_V(2); PG8_BAR;
        PG8_STAGE(PG8_SB(1, 0), cB + kstep, voffB); PG8_STAGE(PG8_SA(1, 0), cA + kstepA, voffA); PG8_STAGE(PG8_SB(1, 1), cB + hstep + kstep, voffB);
        PG8_WAIT_V(6); PG8_BAR;
    } else {
        PG8_STAGE(PG8_SB(0, 0), cB, voffB); PG8_STAGE(PG8_SA(0, 0), cA, voffA); PG8_STAGE(PG8_SB(0, 1), cB + hstep, voffB); PG8_STAGE(PG8_SA(0, 1), cA + hstepA, voffA);
        if (wr == 1) PG8_BAR;
        PG8_WAIT_V(4); PG8_BAR;
        PG8_STAGE(PG8_SB(1, 0), cB + kstep, voffB); PG8_STAGE(PG8_SA(1, 0), cA + kstepA, voffA); PG8_STAGE(PG8_SB(1, 1), cB + hstep + kstep, voffB);
        PG8_WAIT_V(6); PG8_BAR;
    }
    for (;;) {
        const bool has_next = S.next(ui + 1, nxt);
        const char* nA = has_next ? (const char*)g.A + (size_t)nxt.pm * tstepA : cA; const char* nB = has_next ? (const char*)g.Bt + (size_t)nxt.pn * tstep : cB;
        for (int t = 0; t < nt; t += 2) {
            if constexpr (Epi::MID) { if (t == nt / 2) E.mid(acc, cur, wr, wc, fr, fq); }
            const bool last = (t == nt - 2);
            const char* a1 = cA + (size_t)(t + 1) * kstepA;
            const char* a2 = last ? nA : cA + (size_t)(t + 2) * kstepA; const char* b2 = last ? nB : cB + (size_t)(t + 2) * kstep;
            const char* a3 = a2 + kstepA; const char* b3 = b2 + kstep;
            if (last && has_next) S.a_ready(nxt);
            if constexpr (SP2) {
            PG8_LDB(B0, 0, 0); PG8_LDB(B1, 0, 1); PG8_SCHED; PG8_LDA(At, 0, 0); PG8_STAGE(PG8_SA(1, 1), a1 + hstepA, voffA);
            PG8_WAIT_V(8); PG8_WAIT_L(0); PG8_BAR; PG8_MMA(0, 0, At, B0); PG8_MMA(0, 1, At, B1); PG8_BAR; PG8_SCHED;
            PG8_LDA(At, 0, 1); PG8_STAGE(PG8_SB(0, 0), b2, voffB); PG8_STAGE(PG8_SB(0, 1), b2 + hstep, voffB); PG8_STAGE(PG8_SA(0, 0), a2, voffA);
            PG8_WAIT_V(8); PG8_WAIT_L(0); PG8_BAR; PG8_MMA(1, 0, At, B0); PG8_MMA(1, 1, At, B1); PG8_BAR; PG8_SCHED;
            PG8_LDB(B0, 1, 0); PG8_LDB(B1, 1, 1); PG8_SCHED; PG8_LDA(At, 1, 0); PG8_STAGE(PG8_SA(0, 1), a2 + hstepA, voffA);
            PG8_WAIT_V(8); PG8_WAIT_L(0); PG8_BAR; PG8_MMA(0, 0, At, B0); PG8_MMA(0, 1, At, B1); PG8_BAR; PG8_SCHED;
            PG8_LDA(At, 1, 1); PG8_STAGE(PG8_SB(1, 0), b3, voffB); PG8_STAGE(PG8_SB(1, 1), b3 + hstep, voffB); PG8_STAGE(PG8_SA(1, 0), a3, voffA);
            PG8_WAIT_V(8); PG8_WAIT_L(0); PG8_BAR; PG8_MMA(1, 0, At, B0); PG8_MMA(1, 1, At, B1); PG8_BAR; PG8_SCHED;
            } else {
            PG8_LDB(B0, 0, 0); PG8_SCHED; PG8_LDA(At, 0, 0); PG8_STAGE(PG8_SA(1, 1), a1 + hstepA, voffA);
            PG8_WAIT_L(8); PG8_BAR; PG8_WAIT_L(0); PG8_MMA(0, 0, At, B0); PG8_BAR; PG8_SCHED;
            PG8_LDB(B1, 0, 1); PG8_STAGE(PG8_SB(0, 0), b2, voffB);
            PG8_BAR; PG8_WAIT_L(0); PG8_MMA(0, 1, At, B1); PG8_BAR;
            PG8_LDA(At, 0, 1); PG8_STAGE(PG8_SA(0, 0), a2, voffA);
            PG8_BAR; PG8_WAIT_L(0); PG8_MMA(1, 0, At, B0); PG8_BAR; PG8_SCHED;
            PG8_STAGE(PG8_SB(0, 1), b2 + hstep, voffB);
            PG8_WAIT_V(6); PG8_BAR; PG8_MMA(1, 1, At, B1); PG8_BAR;
            PG8_LDB(B0, 1, 0); PG8_SCHED; PG8_LDA(At, 1, 0); PG8_STAGE(PG8_SA(0, 1), a2 + hstepA, voffA);
            PG8_WAIT_L(8); PG8_BAR; PG8_WAIT_L(0); PG8_MMA(0, 0, At, B0); PG8_BAR; PG8_SCHED;
            PG8_LDB(B1, 1, 1); PG8_STAGE(PG8_SB(1, 0), b3, voffB);
            PG8_BAR; PG8_WAIT_L(0); PG8_MMA(0, 1, At, B1); PG8_BAR;
            PG8_LDA(At, 1, 1); PG8_STAGE(PG8_SA(1, 0), a3, voffA);
            PG8_BAR; PG8_WAIT_L(0); PG8_MMA(1, 0, At, B0); PG8_BAR; PG8_SCHED;
            PG8_STAGE(PG8_SB(1, 1), b3 + hstep, voffB);
            PG8_WAIT_V(6); PG8_BAR; PG8_MMA(1, 1, At, B1); PG8_BAR;
            }
        }
        if constexpr (ALIGN_EPI) { if (wr == 0) PG8_BAR; }
        if constexpr (!Epi::AFTER_DRAIN) { E(acc, cur, wr, wc, fr, fq); S.done(cur); }
        if (!has_next) break;
#pragma unroll
        for (int a = 0; a < 2; ++a)
#pragma unroll
            for (int b = 0; b < 2; ++b)
#pragma unroll
                for (int m = 0; m < 4; ++m)
#pragma unroll
                    for (int n = 0; n < 2; ++n) acc[a][b][m][n] = (f32x4){0.f, 0.f, 0.f, 0.f};
        cur = nxt; cA = nA; cB = nB; ++ui;
        if constexpr (ALIGN_EPI) { if (wr == 1) PG8_BAR; }
    }
    PG8_WAIT_V(0);
    if constexpr (!ALIGN_EPI) { if (wr == 0) PG8_BAR; }
    PG8_BAR;
    if constexpr (Epi::AFTER_DRAIN) { E.fused(acc, cur, wr, wc, fr, fq, lds, wid, lane); S.done(cur); }
#undef PG8_SA
#undef PG8_SB
#undef PG8_STAGE
#undef PG8_LDA
#undef PG8_LDB
#undef PG8_MMA
#undef PG8_WAIT_V
#undef PG8_WAIT_L
#undef PG8_BAR
#undef PG8_SCHED
}
}


constexpr int NWAVES = 8;
constexpr int BATCH = 4, SEQ = 8192, D = 1024, M = BATCH * SEQ;
constexpr int NH = 8, HD = 64, NKV = 2, AW = 512, CW = 512, INC = 2304, FF = 4096;
constexpr int O_K = 512, O_V = 640, O_B = 768, O_U = 1280, ZLD = 1792;
constexpr float EPS = 1e-6f;
constexpr float LOG2E = 1.4426950408889634f;

constexpr size_t MiB = 1u << 20;
constexpr size_t WS_WIN = 2 * MiB, WS_WOUT = 8 * MiB, WS_WUP = 10 * MiB, WS_WDN = 18 * MiB;
constexpr size_t WS_PART = 26 * MiB;
constexpr size_t WS_RA = 28 * MiB;
constexpr size_t WS_RMSX = 29 * MiB;
constexpr size_t WS_X1B = 32 * MiB;
constexpr size_t WS_XN = 352 * MiB;
constexpr size_t WS_Z = 96 * MiB;
constexpr size_t WS_Y = 416 * MiB;
constexpr size_t WS_H = 96 * MiB;
constexpr size_t WS_END = 480 * MiB;

constexpr int LDS_BYTES = 147456;
constexpr int KS_STRIDE = 144, VT_STRIDE = 520;
constexpr int LDS_KS = 0, LDS_VT = 2 * 256 * KS_STRIDE, LDS_SS = LDS_VT + 2 * 64 * VT_STRIDE;
constexpr int LDS_MISC = LDS_BYTES - 64;
static_assert(LDS_SS + 128 * 8 * 4 <= LDS_MISC, "attention LDS map");

#define GAS __attribute__((address_space(1)))
#define LAS __attribute__((address_space(3)))
typedef unsigned short bf16;
typedef unsigned v4u __attribute__((ext_vector_type(4)));
typedef unsigned v2u __attribute__((ext_vector_type(2)));
typedef float f32x4 __attribute__((ext_vector_type(4)));
typedef float f32x16 __attribute__((ext_vector_type(16)));
typedef short bf16x8 __attribute__((ext_vector_type(8)));
#define LDS_WAIT() asm volatile("s_waitcnt lgkmcnt(0)" ::: "memory")
__device__ __forceinline__ unsigned f2bf(float f) { unsigned u = __builtin_bit_cast(unsigned, f); return (u + 0x7fffu + ((u >> 16) & 1u)) >> 16; }
__device__ __forceinline__ unsigned pk2(float lo, float hi) { return f2bf(lo) | (f2bf(hi) << 16); }
__device__ __forceinline__ float bflo(unsigned w) { return __builtin_bit_cast(float, w << 16); }
__device__ __forceinline__ float bfhi(unsigned w) { return __builtin_bit_cast(float, w & 0xffff0000u); }
__device__ __forceinline__ void unpack8(const v4u w, float (&f)[8]) { f[0] = bflo(w.x); f[1] = bfhi(w.x); f[2] = bflo(w.y); f[3] = bfhi(w.y); f[4] = bflo(w.z); f[5] = bfhi(w.z); f[6] = bflo(w.w); f[7] = bfhi(w.w); }
__device__ __forceinline__ float wave_sum(float v) {
#pragma unroll
    for (int o = 1; o < 64; o <<= 1) v += __shfl_xor(v, o);
    return v;
}

#define XB_TMO      128
#define XB_XCNT(j)  (256  + 64 * (j))
#define XB_XSUB(j)  (1280 + 64 * (j))
#define XB_XGEN(j)  (2304 + 64 * (j))
#define XB_TOP      3328
#define XB_TOPGEN   3392
#define XCD_BAR_WORDS 3456
#define XB_SPIN_CAP (1u << 18)

__device__ __forceinline__ unsigned xb_ld(unsigned* p)              { return __hip_atomic_load(p, __ATOMIC_RELAXED, __HIP_MEMORY_SCOPE_AGENT); }
__device__ __forceinline__ unsigned xb_add(unsigned* p, unsigned v) { return __hip_atomic_fetch_add(p, v, __ATOMIC_RELAXED, __HIP_MEMORY_SCOPE_AGENT); }
__device__ __forceinline__ unsigned xb_xcc_id() { return (unsigned)__builtin_amdgcn_s_getreg((3 << 11) | 20) & 0xFu; }
#define XB_SPIN(cond, bar) do { unsigned _sp = 0; while (cond) { __builtin_amdgcn_s_sleep(1); \
    if ((++_sp & 255u) == 0u) { if (xb_ld(&(bar)[XB_TMO])) break; if (_sp > XB_SPIN_CAP) { atomicAdd(&(bar)[XB_TMO], 1u); break; } } } } while (0)

struct XcdBarrier {
    unsigned* bar; unsigned x;
    volatile LAS unsigned* st;
};

__device__ __forceinline__ XcdBarrier xcd_barrier_post(unsigned* bar, volatile LAS unsigned* st) {
    XcdBarrier b; b.bar = bar; b.x = xb_xcc_id(); b.st = st;
    if (threadIdx.x == 0) (void)xb_add(&bar[XB_XCNT(b.x)], 1u);
    return b;
}
__device__ __forceinline__ void xcd_barrier_complete(unsigned* bar, unsigned x, unsigned& nloc, unsigned& nx) {
    const unsigned G = gridDim.x * gridDim.y * gridDim.z;
    unsigned sum, cnt, mine, sp = 0u;
    for (;;) {
        sum = 0u; cnt = 0u; mine = 0u;
#pragma unroll
        for (unsigned j = 0; j < 16; ++j) { const unsigned c = xb_ld(&bar[XB_XCNT(j)]); sum += c; cnt += (c > 0u) ? 1u : 0u; mine = (j == x) ? c : mine; }
        if (sum == G) break;
        __builtin_amdgcn_s_sleep(1);
        if ((++sp & 255u) == 0u) { if (xb_ld(&bar[XB_TMO])) break; if (sp > XB_SPIN_CAP) { atomicAdd(&bar[XB_TMO], 1u); break; } }
    }
    nloc = mine > 0u ? mine : 1u; nx = cnt > 0u ? cnt : 1u;
}

__device__ __forceinline__ void xcd_barrier(const XcdBarrier& b) {
    asm volatile("s_waitcnt vmcnt(0)" ::: "memory");
    __syncthreads();
    if (threadIdx.x == 0) {
        unsigned* bar = b.bar;
        __builtin_amdgcn_s_waitcnt(0);
        unsigned nloc = b.st[0], nx = b.st[1];
        if (nloc == 0u) { xcd_barrier_complete(bar, b.x, nloc, nx); b.st[0] = nloc; b.st[1] = nx; }
        const unsigned old = xb_add(&bar[XB_XSUB(b.x)], 1u);
        const unsigned gen = old / nloc;
        if (old + 1u == (gen + 1u) * nloc) {
            __builtin_amdgcn_fence(__ATOMIC_RELEASE, "agent");
            asm volatile("s_waitcnt vmcnt(0)" ::: "memory");
            const unsigned og = xb_add(&bar[XB_TOP], 1u);
            const unsigned tg = og / nx;
            if (og + 1u == (tg + 1u) * nx) xb_add(&bar[XB_TOPGEN], 1u);
            else XB_SPIN(xb_ld(&bar[XB_TOPGEN]) == tg, bar);
            __builtin_amdgcn_fence(__ATOMIC_ACQUIRE, "agent");
            xb_add(&bar[XB_XGEN(b.x)], 1u);
            asm volatile("s_waitcnt vmcnt(0)" ::: "memory");
        } else {
            XB_SPIN(xb_ld(&bar[XB_XGEN(b.x)]) == gen, bar);
            __builtin_amdgcn_fence(__ATOMIC_ACQUIRE, "agent");
            asm volatile("s_waitcnt vmcnt(0)" ::: "memory");
        }
    }
    __syncthreads();
}

__device__ __forceinline__ void group_barrier(unsigned* cnt, unsigned gs, bool light) {
    asm volatile("s_waitcnt vmcnt(0)" ::: "memory");
    __syncthreads();
    if (threadIdx.x == 0) {
        if (!light) { __builtin_amdgcn_fence(__ATOMIC_RELEASE, "agent"); asm volatile("s_waitcnt vmcnt(0)" ::: "memory"); }
        const unsigned old = xb_add(cnt, 1u);
        const unsigned target = (old / gs + 1u) * gs;
        unsigned sp = 0u;
        while (xb_ld(cnt) < target) { __builtin_amdgcn_s_sleep(1); if (++sp > (1u << 22)) break; }
        if (!light) { __builtin_amdgcn_fence(__ATOMIC_ACQUIRE, "agent"); asm volatile("s_waitcnt vmcnt(0)" ::: "memory"); }
    }
    __syncthreads();
}

struct Args { const float* in[13]; float* out; unsigned char* ws; int use_cg_sync; int pad; };

template <bool GATEPERM = false>
__device__ __forceinline__ void p0_transpose_item(const float* W, int K, int N, bf16* WT, const float* g0, const float* g1, int ksplit, LAS float* scr, int item, int lane) {
    const int nblk = N / 32, kb = item / nblk, nb = item % nblk, k0 = 64 * kb, n0 = 32 * nb;
    int sn0 = n0;
    if (GATEPERM && n0 >= 1280) { const int t = (n0 - 1280) >> 8, w = (n0 - 1280) & 255; sn0 = (w < 128) ? 1280 + 128 * t + w : 1792 + 128 * t + (w - 128); }
#pragma unroll 1
    for (int h = 0; h < 2; ++h) {
        float v[16];
        const float* Wp = W + (size_t)(k0 + 32 * h + (lane >> 5)) * N + sn0 + (lane & 31);
#pragma unroll
        for (int i = 0; i < 16; ++i) v[i] = __builtin_nontemporal_load(Wp + (size_t)(2 * i) * N);
#pragma unroll
        for (int i = 0; i < 16; ++i) { const int kk = 2 * (16 * h + i) + (lane >> 5); const int k = k0 + kk;
            const float g = g0 ? (k < ksplit ? g0[k] : g1[k - ksplit]) : 1.0f;
            scr[kk * 33 + (lane & 31)] = v[i] * g; }
    }
    LDS_WAIT(); asm volatile("" ::: "memory");
    const int c = lane & 7;
#pragma unroll
    for (int j = 0; j < 4; ++j) { const int n = (lane >> 3) + 8 * j; const LAS float* s = scr + (8 * c) * 33 + n;
        v4u o; o.x = pk2(s[0 * 33], s[1 * 33]); o.y = pk2(s[2 * 33], s[3 * 33]); o.z = pk2(s[4 * 33], s[5 * 33]); o.w = pk2(s[6 * 33], s[7 * 33]);
        *(GAS v4u*)(WT + (size_t)(n0 + n) * K + k0 + 8 * c) = o; }
    LDS_WAIT(); asm volatile("" ::: "memory");
}
__device__ __forceinline__ void rms_rows2_to_bf16(const float* x, bf16* xn, float* rmsx, int m, int m2, int lane) {
    const GAS f32x4* xa = (const GAS f32x4*)(x + (size_t)m * D) + lane; const GAS f32x4* xb = (const GAS f32x4*)(x + (size_t)m2 * D) + lane;
    f32x4 va[4], vb[4]; float sa = 0.f, sb = 0.f;
#pragma unroll
    for (int j = 0; j < 4; ++j) { va[j] = __builtin_nontemporal_load(xa + 64 * j); vb[j] = __builtin_nontemporal_load(xb + 64 * j); }
#pragma unroll
    for (int j = 0; j < 4; ++j) { sa += (va[j].x * va[j].x + va[j].y * va[j].y) + (va[j].z * va[j].z + va[j].w * va[j].w); sb += (vb[j].x * vb[j].x + vb[j].y * vb[j].y) + (vb[j].z * vb[j].z + vb[j].w * vb[j].w); }
    const float qa = sqrtf(wave_sum(sa) * (1.f / D) + EPS), qb = sqrtf(wave_sum(sb) * (1.f / D) + EPS); const float ra = 1.0f / qa, rb = 1.0f / qb;
    if (lane == 0) { rmsx[m] = qa; rmsx[m2] = qb; }
    GAS unsigned long long* oa = (GAS unsigned long long*)(xn + (size_t)m * D) + lane; GAS unsigned long long* ob = (GAS unsigned long long*)(xn + (size_t)m2 * D) + lane;
#pragma unroll
    for (int j = 0; j < 4; ++j) { oa[64 * j] = (unsigned long long)pk2(va[j].x * ra, va[j].y * ra) | ((unsigned long long)pk2(va[j].z * ra, va[j].w * ra) << 32);
                                  ob[64 * j] = (unsigned long long)pk2(vb[j].x * rb, vb[j].y * rb) | ((unsigned long long)pk2(vb[j].z * rb, vb[j].w * rb) << 32); }
}

__device__ __forceinline__ void attn_conv_unit(LAS unsigned char* lds, int unit, const bf16* Z, bf16* Y, float* RA,
                                               const float* qg, const float* kg, const float* sinks, const float* convw) {
    const int tid = threadIdx.x, lane = tid & 63, wave = __builtin_amdgcn_readfirstlane(tid >> 6);
    const int b = unit >> 6, qb = unit & 63;
    const size_t tok0 = (size_t)b * SEQ + (size_t)qb * 128;
    {
        v4u kw[8], vw[8];
#pragma unroll
        for (int i = 0; i < 8; ++i) {
            const int c = tid + 512 * i, kvh = c >> 11, key = (c >> 3) & 255, part = c & 7;
            kw[i] = (v4u){0u, 0u, 0u, 0u};
            if ((qb > 0) || (key >= 128)) kw[i] = *(const GAS v4u*)(Z + (tok0 + key - 128) * ZLD + O_K + kvh * 64 + part * 8);
        }
#pragma unroll
        for (int i = 0; i < 8; ++i) {
            const int key = tid & 255, kp = (tid >> 8) + 2 * i, kvh = kp >> 3, part = kp & 7;
            vw[i] = (v4u){0u, 0u, 0u, 0u};
            if ((qb > 0) || (key >= 128)) vw[i] = *(const GAS v4u*)(Z + (tok0 + key - 128) * ZLD + O_V + kvh * 64 + part * 8);
        }
#pragma unroll
        for (int i = 0; i < 8; ++i) {
            const int c = tid + 512 * i, kvh = c >> 11, key = (c >> 3) & 255, part = c & 7;
            float f[8]; unpack8(kw[i], f);
            float ss = 0.f;
#pragma unroll
            for (int e = 0; e < 8; ++e) ss += f[e] * f[e];
            ss += __shfl_xor(ss, 1); ss += __shfl_xor(ss, 2); ss += __shfl_xor(ss, 4);
            const float r = 1.0f / sqrtf(ss * (1.0f / 64.0f) + EPS);
            const f32x4 g0 = *(const f32x4*)(kg + part * 8), g1 = *(const f32x4*)(kg + part * 8 + 4);
            v4u o; o.x = pk2(f[0] * r * g0[0], f[1] * r * g0[1]); o.y = pk2(f[2] * r * g0[2], f[3] * r * g0[3]); o.z = pk2(f[4] * r * g1[0], f[5] * r * g1[1]); o.w = pk2(f[6] * r * g1[2], f[7] * r * g1[3]);
            *(LAS v4u*)(lds + LDS_KS + (kvh * 256 + key) * KS_STRIDE + part * 16) = o;
        }
#pragma unroll
        for (int i = 0; i < 8; ++i) {
            const int key = tid & 255, kp = (tid >> 8) + 2 * i, kvh = kp >> 3, part = kp & 7;
            const v4u w = vw[i];
            LAS unsigned short* vt = (LAS unsigned short*)(lds + LDS_VT + (kvh * 64 + part * 8) * VT_STRIDE + key * 2);
            vt[0 * (VT_STRIDE / 2)] = (unsigned short)(w.x & 0xffffu); vt[1 * (VT_STRIDE / 2)] = (unsigned short)(w.x >> 16);
            vt[2 * (VT_STRIDE / 2)] = (unsigned short)(w.y & 0xffffu); vt[3 * (VT_STRIDE / 2)] = (unsigned short)(w.y >> 16);
            vt[4 * (VT_STRIDE / 2)] = (unsigned short)(w.z & 0xffffu); vt[5 * (VT_STRIDE / 2)] = (unsigned short)(w.z >> 16);
            vt[6 * (VT_STRIDE / 2)] = (unsigned short)(w.w & 0xffffu); vt[7 * (VT_STRIDE / 2)] = (unsigned short)(w.w >> 16);
        }
    }
    {
        const int c0 = 8 * lane;
        float w0[8], w1[8], w2[8];
        { const f32x4 a0 = *(const f32x4*)(convw + c0), a1 = *(const f32x4*)(convw + c0 + 4), b0 = *(const f32x4*)(convw + CW + c0), b1 = *(const f32x4*)(convw + CW + c0 + 4),
                      d0 = *(const f32x4*)(convw + 2 * CW + c0), d1 = *(const f32x4*)(convw + 2 * CW + c0 + 4);
#pragma unroll
          for (int e = 0; e < 4; ++e) { w0[e] = a0[e]; w0[4 + e] = a1[e]; w1[e] = b0[e]; w1[4 + e] = b1[e]; w2[e] = d0[e]; w2[4 + e] = d1[e]; } }
        const size_t tokw = tok0 + 16 * wave;
        float u1[8], u2[8];
#pragma unroll
        for (int e = 0; e < 8; ++e) { u1[e] = 0.f; u2[e] = 0.f; }
        if (qb > 0 || wave > 0) {
            unpack8(*(const GAS v4u*)(Z + (tokw - 1) * ZLD + O_U + c0), u1);
            unpack8(*(const GAS v4u*)(Z + (tokw - 2) * ZLD + O_U + c0), u2);
        }
#pragma unroll 4
        for (int i = 0; i < 16; ++i) {
            const size_t tok = tokw + i;
            float fb[8], fu[8];
            unpack8(__builtin_nontemporal_load((const GAS v4u*)(Z + tok * ZLD + O_B + c0)), fb); unpack8(__builtin_nontemporal_load((const GAS v4u*)(Z + tok * ZLD + O_U + c0)), fu);
            float ov[8]; float ss = 0.f;
#pragma unroll
            for (int e = 0; e < 8; ++e) { const float u0 = fu[e]; const float cv = w0[e] * u2[e] + w1[e] * u1[e] + w2[e] * u0; ov[e] = fb[e] * cv; ss += ov[e] * ov[e]; u2[e] = u1[e]; u1[e] = u0; }
            const float r = 1.0f / sqrtf(wave_sum(ss) * (1.0f / CW) + EPS);
            v4u o; o.x = pk2(ov[0] * r, ov[1] * r); o.y = pk2(ov[2] * r, ov[3] * r); o.z = pk2(ov[4] * r, ov[5] * r); o.w = pk2(ov[6] * r, ov[7] * r);
            *(GAS v4u*)(Y + tok * D + AW + c0) = o;
        }
    }
    __syncthreads();
    {
        const int h = wave, kvh = h >> 2, r32 = lane & 31, hi = lane >> 5;
        const float sink2 = sinks[h] * LOG2E;
        const LAS unsigned char* ksb = lds + LDS_KS + (kvh * 256 + r32) * KS_STRIDE + hi * 16;
        const LAS unsigned char* vtb = lds + LDS_VT + (kvh * 64 + r32) * VT_STRIDE + hi * 8;
        LAS float* SS = (LAS float*)(lds + LDS_SS);
#pragma unroll 1
        for (int j = 0; j < 4; ++j) {
            const size_t tokq = tok0 + 32 * j + r32;
            bf16x8 qf[4];
            {
                v4u qw[4]; float ss = 0.f;
#pragma unroll
                for (int ks = 0; ks < 4; ++ks) qw[ks] = __builtin_nontemporal_load((const GAS v4u*)(Z + tokq * ZLD + h * 64 + ks * 16 + hi * 8));
#pragma unroll
                for (int ks = 0; ks < 4; ++ks) { float f[8]; unpack8(qw[ks], f);
#pragma unroll
                    for (int e = 0; e < 8; ++e) ss += f[e] * f[e]; }
                ss += __shfl_xor(ss, 32);
                const float r = (1.0f / sqrtf(ss * (1.0f / 64.0f) + EPS)) * (0.125f * LOG2E);
#pragma unroll
                for (int ks = 0; ks < 4; ++ks) { float f[8]; unpack8(qw[ks], f);
                    const f32x4 g0 = *(const f32x4*)(qg + ks * 16 + hi * 8), g1 = *(const f32x4*)(qg + ks * 16 + hi * 8 + 4);
                    v4u o; o.x = pk2(f[0] * r * g0[0], f[1] * r * g0[1]); o.y = pk2(f[2] * r * g0[2], f[3] * r * g0[3]); o.z = pk2(f[4] * r * g1[0], f[5] * r * g1[1]); o.w = pk2(f[6] * r * g1[2], f[7] * r * g1[3]);
                    qf[ks] = __builtin_bit_cast(bf16x8, o); }
            }
            f32x16 s[5];
#pragma unroll
            for (int a = 0; a < 5; ++a) {
                f32x16 acc = {};
#pragma unroll
                for (int ks = 0; ks < 4; ++ks) {
                    const bf16x8 kf = *(const LAS bf16x8*)(ksb + (32 * (j + a)) * KS_STRIDE + ks * 32);
                    acc = __builtin_amdgcn_mfma_f32_32x32x16_bf16(kf, qf[ks], acc, 0, 0, 0);
                }
                s[a] = acc;
            }
            const float NEG = -1e30f;
#pragma unroll
            for (int r = 0; r < 16; ++r) { const int c = (r & 3) + 8 * (r >> 2) + 4 * hi;
                if (!(r32 < c)) s[0][r] = NEG;
                if (!(r32 >= c)) s[4][r] = NEG; }
            if (qb == 0) {
#pragma unroll
                for (int a = 0; a < 5; ++a) if (j + a < 4) {
#pragma unroll
                    for (int r = 0; r < 16; ++r) s[a][r] = NEG; }
            }
            float mx = sink2;
#pragma unroll
            for (int a = 0; a < 5; ++a)
#pragma unroll
                for (int r = 0; r < 16; ++r) mx = fmaxf(mx, s[a][r]);
            mx = fmaxf(mx, __shfl_xor(mx, 32));
            float l = 0.f;
#pragma unroll
            for (int a = 0; a < 5; ++a)
#pragma unroll
                for (int r = 0; r < 16; ++r) { const float p = __builtin_amdgcn_exp2f(s[a][r] - mx); s[a][r] = p; l += p; }
            l += __shfl_xor(l, 32);
            l += __builtin_amdgcn_exp2f(sink2 - mx);
            f32x16 o[2]; o[0] = (f32x16){}; o[1] = (f32x16){};
#pragma unroll
            for (int a = 0; a < 5; ++a)
#pragma unroll
                for (int h2 = 0; h2 < 2; ++h2) {
                    v4u pw; pw.x = pk2(s[a][8 * h2 + 0], s[a][8 * h2 + 1]); pw.y = pk2(s[a][8 * h2 + 2], s[a][8 * h2 + 3]); pw.z = pk2(s[a][8 * h2 + 4], s[a][8 * h2 + 5]); pw.w = pk2(s[a][8 * h2 + 6], s[a][8 * h2 + 7]);
                    const bf16x8 pf = __builtin_bit_cast(bf16x8, pw);
#pragma unroll
                    for (int dt = 0; dt < 2; ++dt) {
                        const LAS unsigned char* vp = vtb + dt * 32 * VT_STRIDE + (32 * (j + a) + 16 * h2) * 2;
                        const v2u lo = *(const LAS v2u*)(vp), hi2 = *(const LAS v2u*)(vp + 16);
                        const v4u vw = (v4u){lo.x, lo.y, hi2.x, hi2.y};
                        o[dt] = __builtin_amdgcn_mfma_f32_32x32x16_bf16(__builtin_bit_cast(bf16x8, vw), pf, o[dt], 0, 0, 0);
                    }
                }
            const float inv = 1.0f / l;
            float sq = 0.f;
#pragma unroll
            for (int dt = 0; dt < 2; ++dt)
#pragma unroll
                for (int r = 0; r < 16; ++r) { o[dt][r] *= inv; sq += o[dt][r] * o[dt][r]; }
            sq += __shfl_xor(sq, 32);
            if (hi == 0) SS[(32 * j + r32) * 8 + h] = sq;
            bf16* yrow = Y + tokq * D + h * 64 + 4 * hi;
#pragma unroll
            for (int dt = 0; dt < 2; ++dt)
#pragma unroll
                for (int g = 0; g < 4; ++g) { v2u w; w.x = pk2(o[dt][4 * g + 0], o[dt][4 * g + 1]); w.y = pk2(o[dt][4 * g + 2], o[dt][4 * g + 3]);
                    *(GAS v2u*)(yrow + 32 * dt + 8 * g) = w; }
        }
    }
    __syncthreads();
    if (tid < 128) { const LAS float* SS = (const LAS float*)(lds + LDS_SS) + tid * 8; float s = 0.f;
#pragma unroll
        for (int e = 0; e < 8; ++e) s += SS[e];
        RA[tok0 + tid] = 1.0f / sqrtf(s * (1.0f / AW) + EPS); }
    __syncthreads();
}

#ifndef REP_P0
#define REP_P0 1
#endif
#ifndef REP_P1
#define REP_P1 1
#endif
#ifndef REP_P2
#define REP_P2 1
#endif
#ifndef REP_P3
#define REP_P3 1
#endif
#ifndef REP_P4
#define REP_P4 1
#endif
#ifndef REP_P5
#define REP_P5 1
#endif
#ifndef MLP_SPLIT
#define MLP_SPLIT 2
#endif
#ifndef WS_TOP
#define WS_TOP 0
#endif
#ifndef LIGHT_SEAMS
#define LIGHT_SEAMS 1
#endif
#ifndef REP_SYNC
#define REP_SYNC 1
#endif
#define XSYNC() do { for (int _r = 0; _r < REP_SYNC; ++_r) { if (args.use_cg_sync) grid.sync(); else xcd_barrier(xbar); } } while (0)
__global__ void __launch_bounds__(NWAVES * 64, 2) hymba_fwd(Args args) {
    extern __shared__ __attribute__((aligned(16))) unsigned char lds_raw[];
    LAS unsigned char* lds = (LAS unsigned char*)lds_raw;
    cg::grid_group grid = cg::this_grid();
    const int tid = threadIdx.x, lane = tid & 63, wave = __builtin_amdgcn_readfirstlane(tid >> 6);
    const int G = gridDim.x, bx = blockIdx.x;
    unsigned char* ws = args.ws;
    const float* x = args.in[0]; const float* attn_norm_g = args.in[1]; const float* w_in = args.in[2]; const float* q_norm_g = args.in[3]; const float* k_norm_g = args.in[4];
    const float* sinks = args.in[5]; const float* conv_w = args.in[6]; const float* attn_out_g = args.in[7]; const float* conv_out_g = args.in[8]; const float* w_out = args.in[9];
    const float* mlp_norm_g = args.in[10]; const float* w_up = args.in[11]; const float* w_down = args.in[12];
    float* out = args.out;
    if (tid < 16) ((LAS unsigned*)(lds + LDS_MISC))[tid] = 0u;
    __syncthreads();
    const XcdBarrier xbar = xcd_barrier_post((unsigned*)ws, (volatile LAS unsigned*)(lds + LDS_MISC));
    if (tid == 0) __hip_atomic_fetch_or((unsigned*)ws + 4096 + 64 * (bx & 7) + 16, 1u << xbar.x, __ATOMIC_RELAXED, __HIP_MEMORY_SCOPE_AGENT);
    bf16* Win_t = (bf16*)(ws + WS_WIN); bf16* Wout_t = (bf16*)(ws + WS_WOUT); bf16* Wup_t = (bf16*)(ws + WS_WUP); bf16* Wdn_t = (bf16*)(ws + WS_WDN);
    float* PART = (float*)(ws + WS_PART); float* RA = (float*)(ws + WS_RA); float* RMSX = (float*)(ws + WS_RMSX);
    bf16* X1B = (bf16*)(ws + WS_X1B); bf16* XN = (bf16*)(ws + WS_XN); bf16* Z = (bf16*)out;     bf16* Y = (bf16*)(ws + WS_Y); bf16* H = (bf16*)(ws + WS_H);

    for (int rep = 0; rep < REP_P0; ++rep) {
        LAS float* scr = (LAS float*)(lds + wave * 16384);
        const int gw = bx * NWAVES + wave, NGW = G * NWAVES;
        constexpr int I_IN = (D / 64) * (INC / 32), I_OUT = (D / 64) * (D / 32);
        constexpr int NITEMS = I_IN + I_OUT;
        for (int it = gw; it < NITEMS; it += NGW) {
            int r = it;
            if (r < I_IN) { p0_transpose_item<true>(w_in, D, INC, Win_t, attn_norm_g, attn_norm_g, D, scr, r, lane); continue; } r -= I_IN;
            p0_transpose_item(w_out, D, D, Wout_t, attn_out_g, conv_out_g, AW, scr, r, lane);
        }
        for (int m = gw; m < M / 2; m += NGW) rms_rows2_to_bf16(x, XN, RMSX, m, m + M / 2, lane);
    }
    XSYNC();
    {
        pg8::Gemm g{XN, Win_t, M, INC, D}; pg8::StaticOrder S; S.init(M, INC, G, bx); S.sh = REP_P1 - 1;
        pg8::EpiStoreZ E{Z, ZLD};
        pg8::gemm_phase<pg8::EpiStoreZ, pg8::StaticOrder, true, true>(lds, g, S, E);
        constexpr int NWG1 = (M / 256) * (INC / 256);
        const int nfull = NWG1 % G, nidle = G - nfull;
        if (bx >= nfull) {
            LAS float* scr = (LAS float*)(lds + wave * 16384);
            constexpr int I_UP = (D / 64) * (FF / 32), I_DN = (FF / 64) * (D / 32);
            for (int it = (bx - nfull) * NWAVES + wave; it < I_UP + I_DN; it += nidle * NWAVES) {
                if (it < I_UP) p0_transpose_item(w_up, D, FF, Wup_t, mlp_norm_g, mlp_norm_g, D, scr, it, lane);
                else p0_transpose_item(w_down, FF, D, Wdn_t, nullptr, nullptr, 0, scr, it - I_UP, lane);
            }
        }
    }
    XSYNC();
    const int gx = bx & 7; unsigned* gcnt = (unsigned*)ws + 4096 + 64 * gx; const unsigned gsz = (unsigned)((G - gx + 7) >> 3);
    const bool light = __builtin_amdgcn_readfirstlane((int)(__builtin_popcount(xb_ld(gcnt + 16)) == 1)) != 0 && LIGHT_SEAMS;
    unsigned* zdone = (unsigned*)ws + 5120;
    for (int j = bx >> 3; j < 32; j += (int)gsz) attn_conv_unit(lds, 32 * gx + j, Z, Y, RA, q_norm_g, k_norm_g, sinks, conv_w);
    group_barrier(gcnt, gsz, light);
    if (tid == 0) (void)xb_add(zdone, 1u);
    {
        pg8::Gemm g{Y, Wout_t, M, D, D}; pg8::GroupOrder S; S.init(D / 256, 16 * gx, 16, G, bx);
        pg8::EpiResid E{XN, RMSX, X1B, PART, RA};
        pg8::gemm_phase<pg8::EpiResid, pg8::GroupOrder, true, true>(lds, g, S, E);
    }
    group_barrier(gcnt, gsz, light);
    {
        pg8::Gemm g{X1B, Wup_t, M, FF, D}; pg8::GroupOrder S; S.init(FF / 256, 16 * gx, 16, G, bx);
        pg8::EpiRelu2 E{H, FF, PART, EPS};
        pg8::gemm_phase<pg8::EpiRelu2, pg8::GroupOrder, true, true, true>(lds, g, S, E);
    }
    group_barrier(gcnt, gsz, light);
    if (tid == 0) { unsigned sp = 0u; while (xb_ld(zdone) < (unsigned)G) { __builtin_amdgcn_s_sleep(1); if (++sp > (1u << 22)) break; } }
    __syncthreads();
    {
        pg8::Gemm g{H, Wdn_t, M, D, FF}; pg8::GroupOrder S; S.init(D / 256, 16 * gx, 16, G, bx); S.rev = 1;
        pg8::EpiFinal E{X1B, out};
        pg8::gemm_phase<pg8::EpiFinal, pg8::GroupOrder, true, true, true>(lds, g, S, E);
    }
}

extern "C" void kernel_launch(void* const* d_in, const int* in_sizes, int n_in, void* d_out, int out_size, void* d_ws, size_t ws_size, hipStream_t stream) {
    static int grid = 0;
    if (grid == 0) {
        if (n_in != 13 || in_sizes[0] != M * D || out_size != M * D || ws_size < WS_END || (M / 256) != 128) { fprintf(stderr, "kernel_launch: unexpected shapes (n_in %d, in0 %d, out %d, ws %zu); nothing launched\n", n_in, n_in > 0 ? in_sizes[0] : -1, out_size, ws_size); grid = -1; return; }
        int dev = 0, cus = 0, per_cu = 0;
        if (hipGetDevice(&dev) != hipSuccess || hipDeviceGetAttribute(&cus, hipDeviceAttributeMultiprocessorCount, dev) != hipSuccess) { grid = -1; return; }
        if (hipFuncSetAttribute((const void*)hymba_fwd, hipFuncAttributeMaxDynamicSharedMemorySize, LDS_BYTES) != hipSuccess) { fprintf(stderr, "kernel_launch: hipFuncSetAttribute failed\n"); grid = -1; return; }
        if (hipOccupancyMaxActiveBlocksPerMultiprocessor(&per_cu, (const void*)hymba_fwd, NWAVES * 64, LDS_BYTES) != hipSuccess || per_cu < 1) { fprintf(stderr, "kernel_launch: occupancy query gave %d\n", per_cu); per_cu = 1; }
        (void)hipGetLastError();
        grid = cus * 1;
        (void)per_cu;
    }
    if (grid < 0) return;
    unsigned char* wsb = (unsigned char*)d_ws + (WS_TOP ? ((ws_size - WS_END) & ~(size_t)(2 * MiB - 1)) : 0);
    if (hipMemsetAsync(wsb, 0, 32768, stream) != hipSuccess) { fprintf(stderr, "kernel_launch: memset failed\n"); return; }
    Args a{};
    for (int i = 0; i < 13; ++i) a.in[i] = (const float*)d_in[i];
    a.out = (float*)d_out; a.ws = wsb; a.use_cg_sync = 0; a.pad = 0;
    void* kargs[] = {&a};
    const hipError_t e = hipLaunchCooperativeKernel((const void*)hymba_fwd, dim3(grid), dim3(NWAVES * 64), kargs, LDS_BYTES, stream);
    if (e != hipSuccess) fprintf(stderr, "kernel_launch: cooperative launch failed: %s (grid %d)\n", hipGetErrorString(e), grid);
}
```
